# Optimizing an MI355X kernel written in HIP

```python
import math
import jax, jax.numpy as jnp
from jax import lax
import numpy as np

D_MODEL = 1024
BATCH = 2
SEQ = 8192
DEPTH = 2
DEC_BATCH = 1
DEC_SEQ = 16384
PAST_LEN = 128

ATTN_WIDTH = 512
POOL_WIDTH = D_MODEL - ATTN_WIDTH
N_DIFF_HEADS = 4
DIFF_HEAD_DIM = 64
V_HEAD_DIM = 2 * DIFF_HEAD_DIM
POOL_WINDOWS = (2, 4, 8, 16)
POOL_GROUP = POOL_WIDTH // len(POOL_WINDOWS)
D_FF = 2816
NUM_BUCKETS = 32
MAX_DISTANCE = 128
Q_BLOCK = 128
RMS_EPS = 1e-6
IN_WIDTH = 3 * ATTN_WIDTH + POOL_WIDTH

kernel_name = "hymba_diffattn_pool_convffn_encoder"


def rms_norm(x, g):
    xf = x.astype(jnp.float32)
    y = xf * lax.rsqrt(jnp.mean(xf * xf, axis=-1, keepdims=True) + RMS_EPS)
    return (y * g.astype(jnp.float32)).astype(x.dtype)


def rel_bucket(rel):
    nb = NUM_BUCKETS // 2
    max_exact = nb // 2
    ret = jnp.where(rel > 0, nb, 0)
    n = jnp.abs(rel)
    nf = jnp.maximum(n, 1).astype(jnp.float32)
    large = max_exact + (jnp.log(nf / max_exact) / math.log(MAX_DISTANCE / max_exact)
                         * (nb - max_exact)).astype(jnp.int32)
    large = jnp.minimum(large, nb - 1)
    return ret + jnp.where(n < max_exact, n, large)


def diff_attention(q, k, v, rel_bias, lam):
    B, S = q.shape[0], q.shape[1]
    nblk = S // Q_BLOCK
    scale = DIFF_HEAD_DIM ** -0.5
    qb = q.reshape(B, nblk, Q_BLOCK, N_DIFF_HEADS, 2, DIFF_HEAD_DIM).transpose(1, 0, 2, 3, 4, 5)
    kpos = jnp.arange(S, dtype=jnp.int32)

    def one_block(args):
        qblk, i = args
        qpos = i * Q_BLOCK + jnp.arange(Q_BLOCK, dtype=jnp.int32)
        bias = rel_bias[rel_bucket(kpos[None, :] - qpos[:, None])]
        bias = jnp.transpose(bias, (2, 0, 1)).astype(jnp.float32)
        s = jnp.einsum('bqhmd,bkhmd->bhmqk', qblk, k,
                       preferred_element_type=jnp.float32) * scale
        s = s + bias[None, :, None]
        p = jax.nn.softmax(s, axis=-1)
        w = p[:, :, 0] - lam * p[:, :, 1]
        return jnp.einsum('bhqk,bkhd->bqhd', w.astype(v.dtype), v)

    out = lax.map(one_block, (qb, jnp.arange(nblk, dtype=jnp.int32)))
    return out.transpose(1, 0, 2, 3, 4).reshape(B, S, N_DIFF_HEADS, V_HEAD_DIM)


def pool_mixer(p, w_pool, pool_scale):
    B, S, _ = p.shape
    pf = p.astype(jnp.float32)
    csum = jnp.concatenate([jnp.zeros((B, 1, POOL_WIDTH), jnp.float32),
                            jnp.cumsum(pf, axis=1)], axis=1)
    t = np.arange(S)
    outs = []
    for g, win in enumerate(POOL_WINDOWS):
        lo = np.clip(t - win // 2, 0, S - 1)
        hi = np.clip(t + win - win // 2 - 1, 0, S - 1)
        cs = slice(g * POOL_GROUP, (g + 1) * POOL_GROUP)
        cg = csum[..., cs]
        total = jnp.take(cg, hi + 1, axis=1) - jnp.take(cg, lo, axis=1)
        cnt = (hi - lo + 1).astype(np.float32)[None, :, None]
        outs.append(total / cnt - pf[..., cs])
    y = jnp.stack(outs, axis=2)
    y = jnp.einsum('bsgc,gcd->bsgd', y, w_pool.astype(jnp.float32)).reshape(B, S, POOL_WIDTH)
    return (y * pool_scale.astype(jnp.float32)).astype(p.dtype)


def encoder_layer(x, i, rel_bias, ln_mix_pre, ln_mix_post, w_in, lam_q, lam_k, head_norm,
                  w_pool, pool_scale, w_out, ln_ffn_pre, ln_ffn_post, w_up, conv_w, conv_b, w_down):
    B, S, _ = x.shape
    h = rms_norm(x, ln_mix_pre[i])
    z = h @ w_in[i]
    q = z[..., :ATTN_WIDTH].reshape(B, S, N_DIFF_HEADS, 2, DIFF_HEAD_DIM)
    k = z[..., ATTN_WIDTH:2 * ATTN_WIDTH].reshape(B, S, N_DIFF_HEADS, 2, DIFF_HEAD_DIM)
    v = z[..., 2 * ATTN_WIDTH:3 * ATTN_WIDTH].reshape(B, S, N_DIFF_HEADS, V_HEAD_DIM)
    p = z[..., 3 * ATTN_WIDTH:]
    lam_init = 0.8 - 0.6 * math.exp(-0.3 * i)
    lq = lam_q[i].astype(jnp.float32)
    lk = lam_k[i].astype(jnp.float32)
    lam = jnp.exp(jnp.sum(lq[0] * lk[0])) - jnp.exp(jnp.sum(lq[1] * lk[1])) + lam_init
    a = diff_attention(q, k, v, rel_bias, lam)
    a = (rms_norm(a, head_norm[i]) * (1.0 - lam_init)).reshape(B, S, ATTN_WIDTH)
    m = pool_mixer(p, w_pool[i], pool_scale[i])
    o = jnp.concatenate([a, m], axis=-1) @ w_out[i]
    x = x + rms_norm(o, ln_mix_post[i])
    u = rms_norm(x, ln_ffn_pre[i]) @ w_up[i]
    up = jnp.pad(u, ((0, 0), (1, 1), (0, 0)))
    cw = conv_w[i]
    u = up[:, :-2] * cw[0] + up[:, 1:-1] * cw[1] + up[:, 2:] * cw[2] + conv_b[i]
    gate, val = jnp.split(u, 2, axis=-1)
    f = (jax.nn.gelu(gate, approximate=True) * val) @ w_down[i]
    return x + rms_norm(f, ln_ffn_post[i])


def setup_inputs(seed: int = 0) -> dict:
    key = jax.random.key(seed)
    ks = jax.random.split(key, 20)
    f32 = jnp.float32
    n = lambda k, s, sc: jax.random.normal(k, s, f32) * sc
    return {
        "x_prompt": n(ks[0], (BATCH, SEQ, D_MODEL), 1.0),
        "x_sample": n(ks[1], (DEC_BATCH, DEC_SEQ, D_MODEL), 1.0),
        "rel_bias": n(ks[2], (NUM_BUCKETS, N_DIFF_HEADS), 0.5),
        "ln_mix_pre": 1.0 + n(ks[3], (DEPTH, D_MODEL), 0.05),
        "ln_mix_post": 1.0 + n(ks[4], (DEPTH, D_MODEL), 0.05),
        "w_in": n(ks[5], (DEPTH, D_MODEL, IN_WIDTH), D_MODEL ** -0.5),
        "lam_q": n(ks[6], (DEPTH, 2, DIFF_HEAD_DIM), 0.1),
        "lam_k": n(ks[7], (DEPTH, 2, DIFF_HEAD_DIM), 0.1),
        "head_norm": 1.0 + n(ks[8], (DEPTH, V_HEAD_DIM), 0.05),
        "w_pool": n(ks[9], (DEPTH, len(POOL_WINDOWS), POOL_GROUP, POOL_GROUP), POOL_GROUP ** -0.5),
        "pool_scale": 1.0 + n(ks[10], (DEPTH, POOL_WIDTH), 0.1),
        "w_out": n(ks[11], (DEPTH, D_MODEL, D_MODEL), D_MODEL ** -0.5),
        "ln_ffn_pre": 1.0 + n(ks[12], (DEPTH, D_MODEL), 0.05),
        "ln_ffn_post": 1.0 + n(ks[13], (DEPTH, D_MODEL), 0.05),
        "w_up": n(ks[14], (DEPTH, D_MODEL, 2 * D_FF), D_MODEL ** -0.5),
        "conv_w": n(ks[15], (DEPTH, 3, 2 * D_FF), 3 ** -0.5),
        "conv_b": n(ks[16], (DEPTH, 2 * D_FF), 0.01),
        "w_down": n(ks[17], (DEPTH, D_FF, D_MODEL), D_FF ** -0.5),
    }


def reference(x_prompt, x_sample, rel_bias, ln_mix_pre, ln_mix_post, w_in, lam_q, lam_k,
              head_norm, w_pool, pool_scale, w_out, ln_ffn_pre, ln_ffn_post, w_up,
              conv_w, conv_b, w_down):
    def trunk(x):
        for i in range(DEPTH):
            x = encoder_layer(x, i, rel_bias, ln_mix_pre, ln_mix_post, w_in, lam_q, lam_k,
                              head_norm, w_pool, pool_scale, w_out, ln_ffn_pre, ln_ffn_post,
                              w_up, conv_w, conv_b, w_down)
        return x
    y_prompt = trunk(x_prompt)
    y_sample = trunk(x_sample)
    return (y_prompt, y_sample)
```

```cpp
#include <hip/hip_runtime.h>
#include <hip/hip_cooperative_groups.h>
#include <cstdio>
#include <cstdint>
namespace cg = cooperative_groups;

#ifndef MK_MULTI
#define MK_MULTI 0
#endif

#define LAS __attribute__((address_space(3)))
typedef unsigned short bf16_t;
typedef short bf16x8 __attribute__((ext_vector_type(8)));
typedef short s16x4 __attribute__((ext_vector_type(4)));
typedef float f32x4 __attribute__((ext_vector_type(4)));
typedef float f32x16 __attribute__((ext_vector_type(16)));
typedef unsigned u32x4 __attribute__((ext_vector_type(4)));
typedef unsigned u32x2 __attribute__((ext_vector_type(2)));

constexpr int MTOK = 32768, DM = 1024, NZ = 2048, DFF = 2816, NUP = 5632, NLAYER = 2;
constexpr int HALF_TOK = 16384, UP_TILES = 66;
constexpr float RMS_EPS = 1e-6f;
constexpr float QSCALE = 0.125f * 1.4426950408889634f;
constexpr float LOG2E = 1.4426950408889634f;

constexpr size_t OFF_WIN = 0, SZ_WIN = (size_t)NZ * DM * 2;
constexpr size_t OFF_WOUT = OFF_WIN + NLAYER * SZ_WIN, SZ_WOUT = (size_t)DM * DM * 2;
constexpr size_t OFF_WUP = OFF_WOUT + NLAYER * SZ_WOUT, SZ_WUP = (size_t)NUP * DM * 2;
constexpr size_t OFF_WDN = OFF_WUP + NLAYER * SZ_WUP, SZ_WDN = (size_t)DM * DFF * 2;
constexpr size_t OFF_SMALL = OFF_WDN + NLAYER * SZ_WDN;
constexpr size_t OFF_RSTD_A = OFF_SMALL, OFF_RSTD_B = OFF_RSTD_A + MTOK * 4;
constexpr size_t OFF_SSQ = OFF_RSTD_B + MTOK * 4;
constexpr size_t OFF_TAB = OFF_SSQ + (size_t)NLAYER * 2 * MTOK * 4;
constexpr size_t OFF_BAR = OFF_TAB + 8192;
constexpr size_t OFF_XB = 50331648 + 4096;
constexpr size_t OFF_Z = 125829120;
constexpr size_t WS_NEED = OFF_Z + (size_t)MTOK * NZ * 2;
constexpr size_t OFF_FH0 = (size_t)HALF_TOK * DFF * 2;
static_assert(OFF_FH0 + (size_t)HALF_TOK * DM * 2 <= (size_t)MTOK * NZ * 2, "F half 0 fits behind G");
static_assert(OFF_BAR + 3456 * 4 <= 50331648, "small region");
static_assert(OFF_XB + (size_t)(MTOK + 512) * DM * 2 <= OFF_Z, "xb region");

constexpr int LDS_BYTES = 149504;

__device__ __forceinline__ unsigned pk2(float lo, float hi) {
    typedef float f32x2_t __attribute__((ext_vector_type(2))); typedef __bf16 bf16x2_t __attribute__((ext_vector_type(2)));
    f32x2_t v = {lo, hi}; bf16x2_t b = __builtin_convertvector(v, bf16x2_t); return __builtin_bit_cast(unsigned, b);
}
__device__ __forceinline__ float bflo(unsigned w) { return __uint_as_float(w << 16); }
__device__ __forceinline__ float bfhi(unsigned w) { return __uint_as_float(w & 0xffff0000u); }
__device__ __forceinline__ int otid() { int t = threadIdx.x; asm volatile("" : "+v"(t)); return t; }
__device__ __forceinline__ float wave_sum(float v) {
#pragma unroll
    for (int o = 1; o < 64; o <<= 1) v += __shfl_xor(v, o);
    return v;
}

namespace pg8 {
constexpr int BM = 256, BK = 64, HALF = 128, HTB = HALF * BK * 2, STAGE_BYTES = 8 * HTB, NXCD = 8, WGM = 8;
__host__ __device__ __forceinline__ int lds_byte(int r, int c) { const int st = (r >> 4) * 2 + (c >> 5), rr = r & 15, cc = c & 31, ob = rr * 64 + cc * 2; return st * 1024 + (ob ^ (((ob >> 9) & 1) << 5)); }
__host__ __device__ __forceinline__ void stage_rc(int b, int& R, int& C) { const int st = b / 1024, sb = b % 1024, swz = sb ^ (((sb >> 9) & 1) << 5); R = (st >> 1) * 16 + swz / 64; C = (st & 1) * 32 + (swz % 64) / 2; }
__host__ __device__ __forceinline__ int perm32(int rho) { const int n = rho >> 4, i = rho & 15; return 8 * (i >> 2) + 4 * n + (i & 3); }

struct Unit { int pm, pn; };
struct Gemm { const bf16_t* A; const bf16_t* Bt; int M, N, K; };

struct StaticOrder {
    int nM, nN, nwg, G, c;
    __device__ void init(int M, int N, int G_, int c_) { nM = M / BM; nN = N / BM; nwg = nM * nN; G = G_; c = c_; }
    __device__ bool next(int i, Unit& u) const {
        const long L = (long)i * G + c; if (L >= nwg) return false;
        int wgid = (int)L; { const int q = nwg / NXCD, r = nwg % NXCD, xcd = wgid % NXCD, off = wgid / NXCD; wgid = (xcd < r ? xcd * (q + 1) : r * (q + 1) + (xcd - r) * q) + off; }
        const int nig = WGM * nN, gid = wgid / nig, fm = gid * WGM, gsz = (nM - fm) < WGM ? (nM - fm) : WGM;
        u.pm = fm + ((wgid % nig) % gsz); u.pn = (wgid % nig) / gsz; return true;
    }
};

struct EpiScale {
    static constexpr bool PERM = true;
    bf16_t* O; int ldc; const float* rs;
    __device__ __forceinline__ void operator()(const f32x4 (&acc)[2][2][4][2], const Unit& u, int wr, int wc, int fr, int fq) const {
        const int row0 = u.pm * BM + wr * 64 + fr, col0 = u.pn * BM + wc * 32 + 8 * fq;
#pragma unroll
        for (int ai = 0; ai < 2; ++ai)
#pragma unroll
            for (int m = 0; m < 4; ++m) {
                const int row = row0 + ai * HALF + m * 16; const float s = rs[row]; bf16_t* rowp = O + (size_t)row * ldc + col0;
#pragma unroll
                for (int bj = 0; bj < 2; ++bj) { const f32x4 v0 = acc[ai][bj][m][0] * s, v1 = acc[ai][bj][m][1] * s; u32x4 w;
                    w.x = pk2(v0[0], v0[1]); w.y = pk2(v0[2], v0[3]); w.z = pk2(v1[0], v1[1]); w.w = pk2(v1[2], v1[3]); *(u32x4*)(rowp + bj * HALF) = w; }
            }
    }
};
struct EpiSsq {
    static constexpr bool PERM = true;
    bf16_t* O; int ldc; float* ssq;
    __device__ __forceinline__ void operator()(const f32x4 (&acc)[2][2][4][2], const Unit& u, int wr, int wc, int fr, int fq) const {
        const int row0 = u.pm * BM + wr * 64 + fr, col0 = u.pn * BM + wc * 32 + 8 * fq;
#pragma unroll
        for (int ai = 0; ai < 2; ++ai)
#pragma unroll
            for (int m = 0; m < 4; ++m) {
                const int row = row0 + ai * HALF + m * 16; bf16_t* rowp = O + (size_t)row * ldc + col0; float q = 0.f;
#pragma unroll
                for (int bj = 0; bj < 2; ++bj) { const f32x4 v0 = acc[ai][bj][m][0], v1 = acc[ai][bj][m][1]; u32x4 w;
                    q += (v0[0] * v0[0] + v0[1] * v0[1]) + (v0[2] * v0[2] + v0[3] * v0[3]) + (v1[0] * v1[0] + v1[1] * v1[1]) + (v1[2] * v1[2] + v1[3] * v1[3]);
                    w.x = pk2(v0[0], v0[1]); w.y = pk2(v0[2], v0[3]); w.z = pk2(v1[0], v1[1]); w.w = pk2(v1[2], v1[3]); *(u32x4*)(rowp + bj * HALF) = w; }
                q += __shfl_xor(q, 16); q += __shfl_xor(q, 32);
                if (fq == 0) atomicAdd(ssq + row, q);
            }
    }
};
__device__ __forceinline__ float gelu_tanh(float x) {
    const float u = x * (1.0f + 0.044715f * x * x);
    const float e = __builtin_amdgcn_exp2f(-2.302208198f * u);
    return x * __builtin_amdgcn_rcpf(1.0f + e);
}
struct EpiUp {
    static constexpr bool PERM = true;
    bf16_t* G; const float* rstd; const float* cw; const float* cb; int T0;
    __device__ __forceinline__ void operator()(const f32x4 (&acc)[2][2][4][2], const Unit& u, int wr, int wc, int fr, int fq) const {
        const int grow0 = 252 * u.pm + 126 * wr - 1 + 8 * fr;
        const int cg0 = 128 * u.pn + 32 * wc + 8 * fq;
        float rs[8]; bool pz[8], nz[8];
#pragma unroll
        for (int i = 0; i < 8; ++i) { const int t = T0 + grow0 + i; const int tc = t < 0 ? 0 : (t > MTOK - 1 ? MTOK - 1 : t); rs[i] = rstd[tc];
            pz[i] = ((t & 8191) == 0) && (t != 24576); nz[i] = (((t + 1) & 8191) == 0) && (t + 1 != 24576); }
#pragma unroll
        for (int n = 0; n < 2; ++n) {
            float res[8][4];
#pragma unroll
            for (int j = 0; j < 4; ++j) {
                const int cg = cg0 + 4 * n + j;
                const float gw0 = cw[cg], gw1 = cw[NUP + cg], gw2 = cw[2 * NUP + cg], gb = cb[cg];
                const float vw0 = cw[DFF + cg], vw1 = cw[NUP + DFF + cg], vw2 = cw[2 * NUP + DFF + cg], vb = cb[DFF + cg];
                float xg[8], xv[8];
#pragma unroll
                for (int i = 0; i < 8; ++i) { xg[i] = acc[i >> 2][0][i & 3][n][j] * rs[i]; xv[i] = acc[i >> 2][1][i & 3][n][j] * rs[i]; }
                const float gp = __builtin_bit_cast(float, __builtin_amdgcn_update_dpp(0, __builtin_bit_cast(int, xg[7]), 0x111, 0xf, 0xf, false));
                const float gn = __builtin_bit_cast(float, __builtin_amdgcn_update_dpp(0, __builtin_bit_cast(int, xg[0]), 0x101, 0xf, 0xf, false));
                const float vp = __builtin_bit_cast(float, __builtin_amdgcn_update_dpp(0, __builtin_bit_cast(int, xv[7]), 0x111, 0xf, 0xf, false));
                const float vn = __builtin_bit_cast(float, __builtin_amdgcn_update_dpp(0, __builtin_bit_cast(int, xv[0]), 0x101, 0xf, 0xf, false));
#pragma unroll
                for (int i = 0; i < 8; ++i) {
                    float pg = i > 0 ? xg[i - 1] : gp, ng = i < 7 ? xg[i + 1] : gn, pv = i > 0 ? xv[i - 1] : vp, nv = i < 7 ? xv[i + 1] : vn;
                    if (pz[i]) { pg = 0.f; pv = 0.f; } if (nz[i]) { ng = 0.f; nv = 0.f; }
                    const float cgv = gw0 * pg + gw1 * xg[i] + gw2 * ng + gb;
                    const float cvv = vw0 * pv + vw1 * xv[i] + vw2 * nv + vb;
                    res[i][j] = gelu_tanh(cgv) * cvv;
                }
            }
#pragma unroll
            for (int i = 0; i < 8; ++i) { const int s = 8 * fr + i, grow = grow0 + i;
                if (s >= 1 && s <= 126 && grow < HALF_TOK) { u32x2 w; w.x = pk2(res[i][0], res[i][1]); w.y = pk2(res[i][2], res[i][3]); *(u32x2*)(G + (size_t)grow * DFF + cg0 + 4 * n) = w; } }
            __builtin_amdgcn_sched_barrier(0);
        }
    }
};

template <class Epi, bool UPMODE>
__device__ __forceinline__ void gemm_phase(LAS unsigned char* lds, const Gemm g, const StaticOrder& S, const Epi& E) {
    const int tid = otid(), wid = __builtin_amdgcn_readfirstlane(tid >> 6), lane = tid & 63, wr = wid >> 2, wc = wid & 3, fr = lane & 15, fq = lane >> 4;
    const int K = g.K, nt = K / BK;
    unsigned voffA[2], voffB[2];
#pragma unroll
    for (int i = 0; i < 2; ++i) { int R, C; stage_rc(tid * 16 + i * 8192, R, C); const int Rb = Epi::PERM ? ((R & ~31) + perm32(R & 31)) : R;
        const int Ra = UPMODE ? (126 * (R >> 6) + 8 * (R & 15) + ((R >> 4) & 3)) : R;
        voffA[i] = (unsigned)(Ra * K + C) * 2u; voffB[i] = (unsigned)(Rb * K + C) * 2u; }
    const size_t kstep = (size_t)(BK * 2);
    const size_t hstepB = (size_t)HALF * K * 2, tstepB = 2 * hstepB;
    const size_t hstepA = UPMODE ? (size_t)4 * K * 2 : hstepB, tstepA = UPMODE ? (size_t)252 * K * 2 : tstepB;
    const unsigned ldsw = (unsigned)wid * 1024u;
    const int aoff = lds_byte(wr * 64 + fr, fq * 8), boff = lds_byte(wc * 32 + fr, fq * 8);
#define PG8_SA(b, h) (((b) * 2 + (h)) * HTB)
#define PG8_SB(b, h) ((4 + (b) * 2 + (h)) * HTB)
#define PG8_STAGE(bufoff, gbase, voff) do { _Pragma("unroll") for (int _i = 0; _i < 2; ++_i) \
        __builtin_amdgcn_global_load_lds((const unsigned*)((const char*)(gbase) + (voff)[_i]), (LAS unsigned*)(lds + (bufoff) + ldsw + _i * 8192), 16, 0, 0); } while (0)
#define PG8_LDA(dst, b, h) do { _Pragma("unroll") for (int m = 0; m < 4; ++m) _Pragma("unroll") for (int k = 0; k < 2; ++k) dst[m][k] = *(const LAS bf16x8*)(lds + PG8_SA(b, h) + aoff + m * 2048 + k * 1024); } while (0)
#define PG8_LDB(dst, b, h) do { _Pragma("unroll") for (int n = 0; n < 2; ++n) _Pragma("unroll") for (int k = 0; k < 2; ++k) dst[n][k] = *(const LAS bf16x8*)(lds + PG8_SB(b, h) + boff + n * 2048 + k * 1024); } while (0)
#define PG8_MMA(ai, bj, At, Bt) do { __builtin_amdgcn_s_setprio(1); _Pragma("unroll") for (int m = 0; m < 4; ++m) _Pragma("unroll") for (int n = 0; n < 2; ++n) _Pragma("unroll") for (int k = 0; k < 2; ++k) \
        acc[ai][bj][m][n] = __builtin_amdgcn_mfma_f32_16x16x32_bf16(Bt[n][k], At[m][k], acc[ai][bj][m][n], 0, 0, 0); __builtin_amdgcn_s_setprio(0); } while (0)
#define PG8_WAIT_V(n) asm volatile("s_waitcnt vmcnt(" #n ")" ::: "memory")
#define PG8_WAIT_L(n) asm volatile("s_waitcnt lgkmcnt(" #n ")" ::: "memory")
#define PG8_BAR __builtin_amdgcn_s_barrier()
#define PG8_SCHED __builtin_amdgcn_sched_barrier(0)
    Unit cur, nxt; int ui = 0;
    if (!S.next(0, cur)) return;
    f32x4 acc[2][2][4][2];
#pragma unroll
    for (int a = 0; a < 2; ++a)
#pragma unroll
        for (int b = 0; b < 2; ++b)
#pragma unroll
            for (int m = 0; m < 4; ++m)
#pragma unroll
                for (int n = 0; n < 2; ++n) acc[a][b][m][n] = (f32x4){0.f, 0.f, 0.f, 0.f};
    bf16x8 At[4][2], B0[2][2], B1[2][2];
    const char* cA = (const char*)g.A + (size_t)cur.pm * tstepA; const char* cB = (const char*)g.Bt + (size_t)cur.pn * tstepB;
    PG8_STAGE(PG8_SB(0, 0), cB, voffB); PG8_STAGE(PG8_SB(0, 1), cB + hstepB, voffB); PG8_STAGE(PG8_SA(0, 0), cA, voffA); PG8_STAGE(PG8_SA(0, 1), cA + hstepA, voffA);
    if (wr == 1) PG8_BAR;
    PG8_WAIT_V(2); PG8_BAR;
    PG8_STAGE(PG8_SB(1, 0), cB + kstep, voffB); PG8_STAGE(PG8_SA(1, 0), cA + kstep, voffA); PG8_STAGE(PG8_SB(1, 1), cB + hstepB + kstep, voffB);
    PG8_WAIT_V(6); PG8_BAR;
    for (;;) {
        const bool has_next = S.next(ui + 1, nxt);
        const char* nA = has_next ? (const char*)g.A + (size_t)nxt.pm * tstepA : cA; const char* nB = has_next ? (const char*)g.Bt + (size_t)nxt.pn * tstepB : cB;
        for (int t = 0; t < nt; t += 2) {
            const bool last = (t == nt - 2);
            const char* a1 = cA + (size_t)(t + 1) * kstep;
            const char* a2 = last ? nA : cA + (size_t)(t + 2) * kstep; const char* b2 = last ? nB : cB + (size_t)(t + 2) * kstep;
            const char* a3 = a2 + kstep; const char* b3 = b2 + kstep;
            PG8_LDB(B0, 0, 0); PG8_LDB(B1, 0, 1); PG8_SCHED; PG8_LDA(At, 0, 0); PG8_STAGE(PG8_SA(1, 1), a1 + hstepA, voffA);
            PG8_WAIT_V(8); PG8_WAIT_L(0); PG8_BAR; PG8_MMA(0, 0, At, B0); PG8_MMA(0, 1, At, B1); PG8_BAR; PG8_SCHED;
            PG8_LDA(At, 0, 1); PG8_STAGE(PG8_SB(0, 0), b2, voffB); PG8_STAGE(PG8_SB(0, 1), b2 + hstepB, voffB); PG8_STAGE(PG8_SA(0, 0), a2, voffA);
            PG8_WAIT_V(8); PG8_WAIT_L(0); PG8_BAR; PG8_MMA(1, 0, At, B0); PG8_MMA(1, 1, At, B1); PG8_BAR; PG8_SCHED;
            PG8_LDB(B0, 1, 0); PG8_LDB(B1, 1, 1); PG8_SCHED; PG8_LDA(At, 1, 0); PG8_STAGE(PG8_SA(0, 1), a2 + hstepA, voffA);
            PG8_WAIT_V(8); PG8_WAIT_L(0); PG8_BAR; PG8_MMA(0, 0, At, B0); PG8_MMA(0, 1, At, B1); PG8_BAR; PG8_SCHED;
            PG8_LDA(At, 1, 1); PG8_STAGE(PG8_SB(1, 0), b3, voffB); PG8_STAGE(PG8_SB(1, 1), b3 + hstepB, voffB); PG8_STAGE(PG8_SA(1, 0), a3, voffA);
            PG8_WAIT_V(8); PG8_WAIT_L(0); PG8_BAR; PG8_MMA(1, 0, At, B0); PG8_MMA(1, 1, At, B1); PG8_BAR; PG8_SCHED;
        }
        if (wr == 0) PG8_BAR;
        E(acc, cur, wr, wc, fr, fq);
        if (!has_next) break;
#pragma unroll
        for (int a = 0; a < 2; ++a)
#pragma unroll
            for (int b = 0; b < 2; ++b)
#pragma unroll
                for (int m = 0; m < 4; ++m)
#pragma unroll
                    for (int n = 0; n < 2; ++n) acc[a][b][m][n] = (f32x4){0.f, 0.f, 0.f, 0.f};
        cur = nxt; cA = nA; cB = nB; ++ui;
        if (wr == 1) PG8_BAR;
    }
    PG8_WAIT_V(0);
    PG8_BAR;
#undef PG8_SA
#undef PG8_SB
#undef PG8_STAGE
#undef PG8_LDA
#undef PG8_LDB
#undef PG8_MMA
#undef PG8_WAIT_V
#undef PG8_WAIT_L
#undef PG8_BAR
#undef PG8_SCHED
}
}

namespace att {
constexpr int KT = 64 * 256, VT = 64 * 256;
constexpr int NST = 3, OFF_K = 0, OFF_V = NST * KT, OFF_SCR = NST * KT + NST * VT, OFF_TAB = OFF_SCR + 8 * 256, LDS_USED = OFF_TAB + 2048;
static_assert(LDS_USED <= LDS_BYTES, "attention LDS");
constexpr float MNEG = -1.0e30f, THR = 8.0f;

__device__ __forceinline__ bf16x8 pack8(const f32x16& p, int b) {
    u32x4 w; w.x = pk2(p[b + 0], p[b + 1]); w.y = pk2(p[b + 2], p[b + 3]); w.z = pk2(p[b + 4], p[b + 5]); w.w = pk2(p[b + 6], p[b + 7]);
    return __builtin_bit_cast(bf16x8, w);
}
typedef float f32x2 __attribute__((ext_vector_type(2)));
__device__ __forceinline__ void glds16(const void* gbase  , unsigned voff, unsigned lds_dst) { unsigned keep;
    asm volatile("s_mov_b32 %0, m0\n\ts_mov_b32 m0, %3\n\ts_nop 0\n\tglobal_load_lds_dwordx4 %1, %2\n\ts_mov_b32 m0, %0" : "=&s"(keep) : "v"(voff), "s"(gbase), "s"(lds_dst) : "memory"); }
__device__ __forceinline__ float max16f(const f32x16& p) { float a, b;
    asm("v_max3_f32 %0, %2, %3, %4\n\tv_max3_f32 %1, %5, %6, %7\n\tv_max3_f32 %0, %0, %8, %9\n\tv_max3_f32 %1, %1, %10, %11\n\tv_max3_f32 %0, %0, %12, %13\n\tv_max3_f32 %1, %1, %14, %15\n\tv_max3_f32 %0, %0, %16, %17\n\tv_max_f32_e32 %0, %0, %1"
        : "=&v"(a), "=&v"(b) : "v"(p[0]), "v"(p[1]), "v"(p[2]), "v"(p[3]), "v"(p[4]), "v"(p[5]), "v"(p[6]), "v"(p[7]), "v"(p[8]), "v"(p[9]), "v"(p[10]), "v"(p[11]), "v"(p[12]), "v"(p[13]), "v"(p[14]), "v"(p[15]));
    return a; }
__device__ __forceinline__ float max3f(float a, float b, float c) { float r; asm("v_max3_f32 %0, %1, %2, %3" : "=v"(r) : "v"(a), "v"(b), "v"(c)); return r; }
__device__ __forceinline__ float max2f(float a, float b) { float r; asm("v_max_f32_e32 %0, %1, %2" : "=v"(r) : "v"(a), "v"(b)); return r; }
typedef short v4i16_t __attribute__((ext_vector_type(4)));
__device__ __forceinline__ s16x4 vtr(const LAS unsigned char* p) { return __builtin_bit_cast(s16x4, __builtin_amdgcn_ds_read_tr16_b64_v4i16((LAS v4i16_t*)p)); }

__device__ __forceinline__ void attn_unit(LAS unsigned char* lds, const bf16_t* Z, bf16_t* A2, const float* tabg, int seq_base, int S, int h, int qb, float lam) {
    const int tid = otid(), w = __builtin_amdgcn_readfirstlane(tid >> 6), lane = tid & 63, r32 = lane & 31, hi = lane >> 5, g4 = lane >> 4, i16 = lane & 15;
    const int rg = w & 3, m = w >> 2;
    LAS unsigned char* Kb = lds + OFF_K; LAS unsigned char* Vb = lds + OFF_V;
    LAS float* scr = (LAS float*)(lds + OFF_SCR) + w * 64;
    LAS float* tab = (LAS float*)(lds + OFF_TAB);
    for (int i = tid; i < 449; i += 512) { int d = i - 224; d = d < -128 ? -128 : (d > 128 ? 128 : d); tab[i] = tabg[h * 257 + d + 128]; }
    const int qlo = qb * 128 + rg * 32;
    bf16x8 qf[4];
    { const bf16_t* qrow = Z + (size_t)(seq_base + qlo + r32) * NZ + h * 128 + m * 64 + 8 * hi;
#pragma unroll
      for (int ds = 0; ds < 4; ++ds) qf[ds] = *(const bf16x8*)(qrow + 16 * ds); }
    const char* kvbase = (const char*)(Z + (size_t)seq_base * NZ + h * 128);
    unsigned koff[2], voff[2];
#pragma unroll
    for (int i = 0; i < 2; ++i) { const int row = (i * 8 + w) * 4 + (lane >> 4), cp = lane & 15;
        koff[i] = (unsigned)(row * NZ + 512 + ((cp ^ (row & 15)) << 3)) * 2u; voff[i] = (unsigned)(row * NZ + 1024 + ((cp ^ (4 * (row & 3))) << 3)) * 2u; }
    const unsigned kb_u = (unsigned)(size_t)Kb + (unsigned)w * 1024u, vb_u = (unsigned)(size_t)Vb + (unsigned)w * 1024u;
#define ATT_STAGE(t_, buf_) do { const char* tb_ = kvbase + (size_t)(t_) * 64 * NZ * 2; unsigned keep_; \
        const unsigned k0_ = (unsigned)__builtin_amdgcn_readfirstlane(kb_u + (buf_) * KT), v0_ = (unsigned)__builtin_amdgcn_readfirstlane(vb_u + (buf_) * VT); \
        asm volatile("s_mov_b32 %0, m0\n\ts_mov_b32 m0, %6\n\ts_nop 0\n\tglobal_load_lds_dwordx4 %1, %5\n\ts_mov_b32 m0, %7\n\ts_nop 0\n\tglobal_load_lds_dwordx4 %3, %5\n\t" \
                     "s_add_u32 m0, %6, 0x2000\n\ts_nop 0\n\tglobal_load_lds_dwordx4 %2, %5\n\ts_add_u32 m0, %7, 0x2000\n\ts_nop 0\n\tglobal_load_lds_dwordx4 %4, %5\n\ts_mov_b32 m0, %0" \
                     : "=&s"(keep_) : "v"(koff[0]), "v"(koff[1]), "v"(voff[0]), "v"(voff[1]), "s"(tb_), "s"(k0_), "s"(v0_) : "memory", "scc"); } while (0)
    ATT_STAGE(0, 0); ATT_STAGE(1, 1);
    asm volatile("s_waitcnt vmcnt(4) lgkmcnt(0)" ::: "memory"); __builtin_amdgcn_s_barrier(); asm volatile("" ::: "memory");
#pragma unroll
    for (int ds = 0; ds < 4; ++ds) asm volatile("" : "+v"(qf[ds]));
    const float tabL = tab[0], tabR = tab[448];
    f32x16 O[4];
#pragma unroll
    for (int d = 0; d < 4; ++d)
#pragma unroll
        for (int r = 0; r < 16; ++r) O[d][r] = 0.f;
    float mu = 0.f; f32x2 ls2 = {0.f, 0.f};
    f32x16 cblk; float coff_cur = __builtin_nanf("");
#pragma unroll
    for (int r = 0; r < 16; ++r) cblk[r] = 0.f;
    const int NT = S >> 6;
    const unsigned kfo = r32 * 256 + ((unsigned)((m * 8 + hi) ^ (r32 & 15)) << 4);
    const unsigned vj = (i16 >> 2) & 3;
    const unsigned vfo = (4 * hi + (i16 >> 2)) * 256 + (vj << 6) + 32 * (g4 & 1) + 8 * (i16 & 3);
    int bc = 0, bn = 2;
    for (int t = 0; t < NT; ++t) {
        if (t + 2 < NT) ATT_STAGE(t + 2, bn);
        const LAS unsigned char* Kt = Kb + bc * KT; const LAS unsigned char* Vt = Vb + bc * VT;
        const int kv0 = t * 64;
        bool near = true; float cc = 0.f;
        if (kv0 - (qlo + 31) >= 128) { near = false; cc = tabR; } else if (qlo - (kv0 + 63) >= 128) { near = false; cc = tabL; }
        { const float coff = cc - mu;
          if (__any(!(coff == coff_cur))) { coff_cur = coff;
#pragma unroll
              for (int r = 0; r < 16; ++r) cblk[r] = coff;
              asm volatile("" : "+v"(cblk)); } }
        f32x16 p0, p1;
        {
            bf16x8 kf[8];
#pragma unroll
            for (int ds = 0; ds < 4; ++ds) { kf[2 * ds] = *(const LAS bf16x8*)(Kt + (kfo ^ (unsigned)(ds << 5))); kf[2 * ds + 1] = *(const LAS bf16x8*)(Kt + 32 * 256 + (kfo ^ (unsigned)(ds << 5))); }
            __builtin_amdgcn_sched_barrier(0);
            p0 = __builtin_amdgcn_mfma_f32_32x32x16_bf16(kf[0], qf[0], cblk, 0, 0, 0);
            p1 = __builtin_amdgcn_mfma_f32_32x32x16_bf16(kf[1], qf[0], cblk, 0, 0, 0);
#pragma unroll
            for (int ds = 1; ds < 4; ++ds) {
                p0 = __builtin_amdgcn_mfma_f32_32x32x16_bf16(kf[2 * ds], qf[ds], p0, 0, 0, 0);
                p1 = __builtin_amdgcn_mfma_f32_32x32x16_bf16(kf[2 * ds + 1], qf[ds], p1, 0, 0, 0);
            }
        }
#define VTR(dst, addr, off) asm volatile("ds_read_b64_tr_b16 %0, %1 offset:%2" : "=v"(dst) : "v"(addr), "i"(off) : "memory")
#define VREADS1(arr, d_) do { const unsigned ad_ = vbase ^ (unsigned)((d_) << 6); __builtin_amdgcn_sched_barrier(0); \
        _Pragma("unroll") for (int ks_ = 0; ks_ < 4; ++ks_) { VTR(arr[ks_ * 2], ad_, ks_ * 4096); VTR(arr[ks_ * 2 + 1], ad_, ks_ * 4096 + 2048); } __builtin_amdgcn_sched_barrier(0); } while (0)
#define PV1(arr, d_) do { _Pragma("unroll") for (int ks_ = 0; ks_ < 4; ++ks_) { const s16x4 lo_ = arr[ks_ * 2], hh_ = arr[ks_ * 2 + 1]; \
        const bf16x8 bv_ = (bf16x8){lo_[0], lo_[1], lo_[2], lo_[3], hh_[0], hh_[1], hh_[2], hh_[3]}; \
        O[d_] = __builtin_amdgcn_mfma_f32_32x32x16_bf16(pa[ks_], bv_, O[d_], 0, 0, 0); } __builtin_amdgcn_sched_barrier(0); } while (0)
#define LGKM0() do { __builtin_amdgcn_sched_barrier(0); asm volatile("s_waitcnt lgkmcnt(0)" ::: "memory"); __builtin_amdgcn_sched_barrier(0); } while (0)
        const unsigned vbase = (unsigned)(size_t)Vt + vfo;
        s16x4 va[8], vb[8];
        VREADS1(va, 0);
        if (near) {
            const LAS float* tp = tab + (kv0 + 4 * hi - (qlo + r32) + 224);
#pragma unroll
            for (int r = 0; r < 16; ++r) { p0[r] += tp[(r & 3) + 8 * (r >> 2)]; p1[r] += tp[32 + (r & 3) + 8 * (r >> 2)]; }
        }
        float mx = max2f(max16f(p0), max16f(p1));
        const bool first = (t == 0);
        if (first || __any(mx > THR)) {
            { auto rr = __builtin_amdgcn_permlane32_swap(__float_as_uint(mx), __float_as_uint(mx), false, false); mx = max2f(__uint_as_float(rr[0]), __uint_as_float(rr[1])); }
            const float delta = first ? mx : fmaxf(mx, 0.f);
            const float alpha = first ? 1.0f : __builtin_amdgcn_exp2f(-delta);
            mu += delta; ls2 *= alpha;
            if (!first) {
                asm volatile("" ::: "memory");
                scr[r32] = alpha;
                asm volatile("s_waitcnt lgkmcnt(0)" ::: "memory");
#pragma unroll
                for (int g = 0; g < 4; ++g) { const f32x4 a4 = *(const LAS f32x4*)(scr + 8 * g + 4 * hi);
#pragma unroll
                    for (int d = 0; d < 4; ++d) { O[d][4 * g + 0] *= a4[0]; O[d][4 * g + 1] *= a4[1]; O[d][4 * g + 2] *= a4[2]; O[d][4 * g + 3] *= a4[3]; } }
                asm volatile("s_waitcnt lgkmcnt(0)" ::: "memory");
            }
#pragma unroll
            for (int r = 0; r < 16; ++r) { p0[r] -= delta; p1[r] -= delta; }
            asm volatile("" : "+v"(p0), "+v"(p1));
        }
#pragma unroll
        for (int r = 0; r < 16; ++r) { p0[r] = __builtin_amdgcn_exp2f(p0[r]); p1[r] = __builtin_amdgcn_exp2f(p1[r]); }
#pragma unroll
        for (int r = 0; r < 16; r += 2) { ls2 += (f32x2){p0[r], p0[r + 1]}; ls2 += (f32x2){p1[r], p1[r + 1]}; }
        bf16x8 pa[4]; pa[0] = pack8(p0, 0); pa[1] = pack8(p0, 8); pa[2] = pack8(p1, 0); pa[3] = pack8(p1, 8);
        LGKM0(); VREADS1(vb, 1); PV1(va, 0); LGKM0(); VREADS1(va, 2); PV1(vb, 1); LGKM0(); VREADS1(vb, 3); PV1(va, 2); LGKM0(); PV1(vb, 3);
#undef VTR
#undef VREADS1
#undef PV1
#undef LGKM0
        if (t + 2 < NT) asm volatile("s_waitcnt vmcnt(4) lgkmcnt(0)" ::: "memory"); else asm volatile("s_waitcnt vmcnt(0) lgkmcnt(0)" ::: "memory");
        __builtin_amdgcn_s_barrier(); asm volatile("" ::: "memory");
        bc = (bc == NST - 1) ? 0 : bc + 1; bn = (bn == NST - 1) ? 0 : bn + 1;
    }
    const float ls = ls2[0] + ls2[1];
#undef ATT_STAGE
    int r32e = r32, hie = hi; asm volatile("" : "+v"(r32e), "+v"(hie));
    const float lt = ls + __shfl_xor(ls, 32);
    asm volatile("" ::: "memory");
    scr[r32e] = (m == 0 ? 1.0f : lam) / lt;
    asm volatile("s_waitcnt lgkmcnt(0)" ::: "memory");
#pragma unroll
    for (int g = 0; g < 4; ++g) { const f32x4 c0 = *(const LAS f32x4*)(scr + 8 * g + 4 * hie);
#pragma unroll
        for (int k = 0; k < 4; ++k)
#pragma unroll
            for (int d = 0; d < 4; ++d) O[d][4 * g + k] *= c0[k]; }
    LAS float* X = (LAS float*)lds + (size_t)rg * 4096 + lane;
    if (m == 1) {
#pragma unroll
        for (int d = 0; d < 4; ++d)
#pragma unroll
            for (int r = 0; r < 16; ++r) X[(d * 16 + r) * 64] = O[d][r];
    }
    __syncthreads();
    if (m == 0) {
        float ss[16];
#pragma unroll
        for (int r = 0; r < 16; ++r) { float q = 0.f;
#pragma unroll
            for (int d = 0; d < 4; ++d) { const float o = O[d][r] - X[(d * 16 + r) * 64]; O[d][r] = o; q += o * o; }
            ss[r] = q; }
#pragma unroll
        for (int r = 0; r < 16; ++r) { float q = ss[r];
#pragma unroll
            for (int o = 1; o < 32; o <<= 1) q += __shfl_xor(q, o);
            ss[r] = __builtin_amdgcn_rsqf(q * (1.0f / 128.0f) + RMS_EPS); }
#pragma unroll
        for (int r = 0; r < 16; ++r) { const int q = (r & 3) + 8 * (r >> 2) + 4 * hie;
            bf16_t* orow = A2 + (size_t)(seq_base + qlo + q) * DM + h * 128 + r32e;
#pragma unroll
            for (int d = 0; d < 4; ++d) orow[d * 32] = (bf16_t)(pk2(O[d][r] * ss[r], 0.f) & 0xffffu); }
    }
    __syncthreads();
}

__device__ __forceinline__ void unpack8(const u32x4 v, float* a) { a[0] = bflo(v.x); a[1] = bfhi(v.x); a[2] = bflo(v.y); a[3] = bfhi(v.y); a[4] = bflo(v.z); a[5] = bfhi(v.z); a[6] = bflo(v.w); a[7] = bfhi(v.w); }
__device__ __forceinline__ void pool_block(const bf16_t* Z, bf16_t* A2, int row0, int lane) {
    int sb, S; if (row0 < 8192) { sb = 0; S = 8192; } else if (row0 < 16384) { sb = 8192; S = 8192; } else { sb = 16384; S = 16384; }
    const int t0 = row0 - sb, g = lane >> 4, hw = 1 << g;
    const bf16_t* base = Z + (size_t)sb * NZ + 1536 + lane * 8;
    float sum[8], tmp[8];
#pragma unroll
    for (int j = 0; j < 8; ++j) sum[j] = 0.f;
    for (int j = 0; j < 16; ++j) { const int r = t0 - hw + j;
        if (j < 2 * hw && r >= 0 && r < S) { unpack8(*(const u32x4*)(base + (size_t)r * NZ), tmp);
#pragma unroll
            for (int e = 0; e < 8; ++e) sum[e] += tmp[e]; } }
    for (int i = 0; i < 16; ++i) { const int t = t0 + i;
        int lo = t - hw; if (lo < 0) lo = 0; int hi2 = t + hw - 1; if (hi2 > S - 1) hi2 = S - 1;
        const float inv = 1.0f / (float)(hi2 - lo + 1);
        float self[8]; unpack8(*(const u32x4*)(base + (size_t)t * NZ), self);
        u32x4 o; o.x = pk2(sum[0] * inv - self[0], sum[1] * inv - self[1]); o.y = pk2(sum[2] * inv - self[2], sum[3] * inv - self[3]);
        o.z = pk2(sum[4] * inv - self[4], sum[5] * inv - self[5]); o.w = pk2(sum[6] * inv - self[6], sum[7] * inv - self[7]);
        *(u32x4*)(A2 + (size_t)(sb + t) * DM + 512 + lane * 8) = o;
        const int radd = t + hw, rsub = t - hw;
        if (radd < S) { unpack8(*(const u32x4*)(base + (size_t)radd * NZ), tmp);
#pragma unroll
            for (int e = 0; e < 8; ++e) sum[e] += tmp[e]; }
        if (rsub >= 0) { unpack8(*(const u32x4*)(base + (size_t)rsub * NZ), tmp);
#pragma unroll
            for (int e = 0; e < 8; ++e) sum[e] -= tmp[e]; }
    }
}
}

#define XB_TMO      128
#define XB_XCNT(j)  (256  + 64 * (j))
#define XB_XSUB(j)  (1280 + 64 * (j))
#define XB_XGEN(j)  (2304 + 64 * (j))
#define XB_TOP      3328
#define XB_TOPGEN   3392
#define XCD_BAR_WORDS 3456
#define XB_SPIN_CAP (1u << 22)
__device__ __forceinline__ unsigned xb_ld(unsigned* p)              { return __hip_atomic_load(p, __ATOMIC_RELAXED, __HIP_MEMORY_SCOPE_AGENT); }
__device__ __forceinline__ unsigned xb_add(unsigned* p, unsigned v) { return __hip_atomic_fetch_add(p, v, __ATOMIC_RELAXED, __HIP_MEMORY_SCOPE_AGENT); }
__device__ __forceinline__ unsigned xb_xcc_id() { return (unsigned)__builtin_amdgcn_s_getreg((3 << 11) | 20) & 0xFu; }
#define XB_SPIN(cond, bar) do { unsigned _sp = 0; while (cond) { __builtin_amdgcn_s_sleep(1); \
    if ((++_sp & 255u) == 0u) { if (xb_ld(&(bar)[XB_TMO])) break; if (_sp > XB_SPIN_CAP) { atomicAdd(&(bar)[XB_TMO], 1u); break; } } } } while (0)
struct XcdBarrier { unsigned* bar; unsigned x; volatile LAS unsigned* st; };
__device__ __forceinline__ XcdBarrier xcd_barrier_post(unsigned* bar, volatile LAS unsigned* st) {
    XcdBarrier b; b.bar = bar; b.x = xb_xcc_id(); b.st = st;
    if (threadIdx.x == 0) (void)xb_add(&bar[XB_XCNT(b.x)], 1u);
    return b;
}
__device__ __forceinline__ void xcd_barrier_complete(unsigned* bar, unsigned x, unsigned& nloc, unsigned& nx) {
    const unsigned G = gridDim.x * gridDim.y * gridDim.z;
    unsigned sum, cnt, mine, sp = 0u;
    for (;;) {
        sum = 0u; cnt = 0u; mine = 0u;
#pragma unroll
        for (unsigned j = 0; j < 16; ++j) { const unsigned c = xb_ld(&bar[XB_XCNT(j)]); sum += c; cnt += (c > 0u) ? 1u : 0u; mine = (j == x) ? c : mine; }
        if (sum == G) break;
        __builtin_amdgcn_s_sleep(1);
        if ((++sp & 255u) == 0u) { if (xb_ld(&bar[XB_TMO])) break; if (sp > XB_SPIN_CAP) { atomicAdd(&bar[XB_TMO], 1u); break; } }
    }
    nloc = mine > 0u ? mine : 1u; nx = cnt > 0u ? cnt : 1u;
}
__device__ __forceinline__ void xcd_barrier(const XcdBarrier& b) {
    asm volatile("s_waitcnt vmcnt(0)" ::: "memory");
    __syncthreads();
    if (threadIdx.x == 0) {
        unsigned* bar = b.bar;
        __builtin_amdgcn_s_waitcnt(0);
        unsigned nloc = b.st[0], nx = b.st[1];
        if (nloc == 0u) { xcd_barrier_complete(bar, b.x, nloc, nx); b.st[0] = nloc; b.st[1] = nx; }
        const unsigned old = xb_add(&bar[XB_XSUB(b.x)], 1u);
        const unsigned gen = old / nloc;
        if (old + 1u == (gen + 1u) * nloc) {
            __builtin_amdgcn_fence(__ATOMIC_RELEASE, "agent");
            asm volatile("s_waitcnt vmcnt(0)" ::: "memory");
            const unsigned og = xb_add(&bar[XB_TOP], 1u);
            const unsigned tg = og / nx;
            if (og + 1u == (tg + 1u) * nx) xb_add(&bar[XB_TOPGEN], 1u);
            else XB_SPIN(xb_ld(&bar[XB_TOPGEN]) == tg, bar);
            __builtin_amdgcn_fence(__ATOMIC_ACQUIRE, "agent");
            xb_add(&bar[XB_XGEN(b.x)], 1u);
            asm volatile("s_waitcnt vmcnt(0)" ::: "memory");
        } else {
            XB_SPIN(xb_ld(&bar[XB_XGEN(b.x)]) == gen, bar);
            __builtin_amdgcn_fence(__ATOMIC_ACQUIRE, "agent");
            asm volatile("s_waitcnt vmcnt(0)" ::: "memory");
        }
    }
    __syncthreads();
}

typedef const char __attribute__((address_space(4)))* karg_t;
__device__ __forceinline__ const float* karg_ptr(int byte_off) { karg_t ka = (karg_t)__builtin_amdgcn_kernarg_segment_ptr(); asm volatile("" : "+s"(ka)); return *(const float* const __attribute__((address_space(4)))*)(ka + byte_off); }
#define PIN(i) karg_ptr(8 * (i))
struct Params { const float* in[18]; float* out; unsigned char* ws; int ph_lo, ph_hi; };
enum { I_XP = 0, I_XS, I_RELB, I_LNMPRE, I_LNMPOST, I_WIN, I_LAMQ, I_LAMK, I_HNORM, I_WPOOL, I_PSCALE, I_WOUT, I_LNFPRE, I_LNFPOST, I_WUP, I_CONVW, I_CONVB, I_WDOWN };
constexpr int NPHASE = 1 + 9 * NLAYER;

template <class Src, class RowMap>
__device__ __forceinline__ void tconv_item(LAS float* scr, bf16_t* WT, int K, int k0, int n0, int lane, const Src& src, const RowMap& rm) {
#pragma unroll 8
    for (int i = 0; i < 32; ++i) { const int kk = 2 * i + (lane >> 5); scr[kk * 33 + (lane & 31)] = src(k0 + kk, n0 + (lane & 31)); }
    asm volatile("s_waitcnt lgkmcnt(0)" ::: "memory");
    const int c = lane & 7;
#pragma unroll
    for (int j = 0; j < 4; ++j) { const int n = (lane >> 3) + 8 * j; const LAS float* s = scr + (8 * c) * 33 + n;
        u32x4 o; o.x = pk2(s[0], s[33]); o.y = pk2(s[2 * 33], s[3 * 33]); o.z = pk2(s[4 * 33], s[5 * 33]); o.w = pk2(s[6 * 33], s[7 * 33]);
        *(u32x4*)(WT + (size_t)rm(n0 + n) * K + k0 + 8 * c) = o; }
    asm volatile("s_waitcnt lgkmcnt(0)" ::: "memory");
}

__device__ __forceinline__ int t5_bucket(int rel) {
    const int ret = rel > 0 ? 16 : 0; const int n = rel < 0 ? -rel : rel;
    if (n < 8) return ret + n;
    int lg = 31 - __clz(n * n);
    int large = 8 + (lg - 6); if (large > 15) large = 15;
    return ret + large;
}

__device__ __forceinline__ void resid_rows(bf16_t* R, const bf16_t* Y, const float* ssqY, const float* g, float* rstd_out, float* outf, bool wf32, int row_lo, int row_hi, int yoff, int gw, int NGW, int lane) {
    for (int row = row_lo + gw; row < row_hi; row += NGW) {
        const float rs = __builtin_amdgcn_rsqf(ssqY[row] * (1.0f / DM) + RMS_EPS); float s = 0.f;
#pragma unroll
        for (int j = 0; j < 2; ++j) { const int c = 8 * lane + 512 * j;
            const u32x4 r = *(const u32x4*)(R + (size_t)row * DM + c), o = *(const u32x4*)(Y + (size_t)(row - yoff) * DM + c);
            const f32x4 ga = *(const f32x4*)(g + c), gb = *(const f32x4*)(g + c + 4);
            f32x4 ya, yb; ya[0] = bflo(r.x) + bflo(o.x) * rs * ga[0]; ya[1] = bfhi(r.x) + bfhi(o.x) * rs * ga[1]; ya[2] = bflo(r.y) + bflo(o.y) * rs * ga[2]; ya[3] = bfhi(r.y) + bfhi(o.y) * rs * ga[3];
            yb[0] = bflo(r.z) + bflo(o.z) * rs * gb[0]; yb[1] = bfhi(r.z) + bfhi(o.z) * rs * gb[1]; yb[2] = bflo(r.w) + bflo(o.w) * rs * gb[2]; yb[3] = bfhi(r.w) + bfhi(o.w) * rs * gb[3];
            if (wf32) { *(f32x4*)(outf + (size_t)row * DM + c) = ya; *(f32x4*)(outf + (size_t)row * DM + c + 4) = yb; }
            s += (ya[0] * ya[0] + ya[1] * ya[1]) + (ya[2] * ya[2] + ya[3] * ya[3]) + (yb[0] * yb[0] + yb[1] * yb[1]) + (yb[2] * yb[2] + yb[3] * yb[3]);
            u32x4 w; w.x = pk2(ya[0], ya[1]); w.y = pk2(ya[2], ya[3]); w.z = pk2(yb[0], yb[1]); w.w = pk2(yb[2], yb[3]); *(u32x4*)(R + (size_t)row * DM + c) = w; }
        s = wave_sum(s); if (lane == 0) rstd_out[row] = __builtin_amdgcn_rsqf(s * (1.0f / DM) + RMS_EPS);
    }
}

__global__ void __launch_bounds__(512, 2) fwd_megakernel(Params P) {
    extern __shared__ __attribute__((aligned(16))) unsigned char lds_raw[];
    LAS unsigned char* lds = (LAS unsigned char*)lds_raw;
    const int tid = threadIdx.x, lane = tid & 63, wave = tid >> 6, G = gridDim.x, bx = blockIdx.x;
    const int gw = bx * 8 + wave, NGW = G * 8;
#define ws ((unsigned char*)karg_ptr(152))
#define XB ((bf16_t*)(ws + OFF_XB))
#define A2 ((bf16_t*)out)
#define FH0 ((bf16_t*)(ws + OFF_Z + OFF_FH0))
#define FH1 ((bf16_t*)out)
#define Zb ((bf16_t*)(ws + OFF_Z))
#define OB Zb
#define GB Zb
#define rstdA ((float*)(ws + OFF_RSTD_A))
#define rstdB ((float*)(ws + OFF_RSTD_B))
#define ssq ((float*)(ws + OFF_SSQ))
#define tabg ((float*)(ws + OFF_TAB))
#define out ((float*)karg_ptr(144))
    volatile LAS unsigned* xst = (volatile LAS unsigned*)(lds + LDS_BYTES - 16);
    if (tid == 0) { xst[0] = 0u; xst[1] = 0u; }
    __syncthreads();
    if (P.ph_hi - P.ph_lo > 1) (void)xcd_barrier_post((unsigned*)(ws + OFF_BAR), xst);
#ifndef PHMASK
#define PHMASK 0xff
#endif
#define EN(t) (((PHMASK) >> (t)) & 1)
#define IN(k) (P.ph_lo <= (k) && (k) < P.ph_hi)
#define SEAM(k) do { if (IN(k) && IN((k) + 1)) { if (P.ph_lo == 0x7fffffff) cg::this_grid().sync();   { XcdBarrier xb_; xb_.bar = (unsigned*)(ws + OFF_BAR); xb_.x = xb_xcc_id(); xb_.st = (volatile LAS unsigned*)(lds + LDS_BYTES - 16); xcd_barrier(xb_); } } } while (0)

    if (EN(0) && IN(0)) {
        { const int lane_ = otid() & 63, wv_ = otid() >> 6, gwv = bx * 8 + wv_, ngw = G * 8;
          LAS float* scr = (LAS float*)lds + wv_ * (64 * 33);
          auto rid = [](int n) { return n; };
          for (int l = 0; l < NLAYER; ++l) {
            const float lam_init = 0.8f - 0.6f * expf(-0.3f * (float)l);
            {
                const float* W = PIN(I_WIN) + (size_t)l * DM * NZ; const float* gpre = PIN(I_LNMPRE) + l * DM; bf16_t* WT = (bf16_t*)(ws + OFF_WIN + l * SZ_WIN);
                auto src = [=](int k, int n) { return W[(size_t)k * NZ + n] * gpre[k] * (n < 512 ? QSCALE : 1.0f); };
                for (int it = gwv; it < 16 * 64; it += ngw) tconv_item(scr, WT, DM, (it >> 6) * 64, (it & 63) * 32, lane_, src, rid);
            }
            {
                const float* W = PIN(I_WOUT) + (size_t)l * DM * DM; const float* hn = PIN(I_HNORM) + l * 128; bf16_t* WT = (bf16_t*)(ws + OFF_WOUT + l * SZ_WOUT); const float hs = 1.0f - lam_init;
                auto src = [=](int k, int n) { return W[(size_t)k * DM + n] * hn[k & 127] * hs; };
                for (int it = gwv; it < 8 * 32; it += ngw) tconv_item(scr, WT, DM, (it >> 5) * 64, (it & 31) * 32, lane_, src, rid);
            }
            {
                const float* W = PIN(I_WOUT) + (size_t)l * DM * DM; const float* wp = PIN(I_WPOOL) + (size_t)l * 4 * 128 * 128; const float* ps = PIN(I_PSCALE) + l * 512;
                bf16_t* WT = (bf16_t*)(ws + OFF_WOUT + l * SZ_WOUT);
                for (int it = gwv; it < 4 * 4 * 32; it += ngw) {
                    const int g = it >> 7, ci = (it >> 5) & 3, nj = it & 31, kh = lane_ >> 5, l31 = lane_ & 31;
                    const float* wrow = wp + ((size_t)g * 128 + ci * 32 + l31) * 128; const float* psg = ps + g * 128; const float* wo = W + (size_t)(512 + g * 128) * DM + nj * 32 + l31;
                    f32x16 acc;
#pragma unroll
                    for (int r = 0; r < 16; ++r) acc[r] = 0.f;
#pragma unroll 8
                    for (int kk = 0; kk < 64; ++kk) { const int d = 2 * kk + kh; acc = __builtin_amdgcn_mfma_f32_32x32x2f32(wrow[d] * psg[d], wo[(size_t)d * DM], acc, 0, 0, 0); }
                    bf16_t* orow = WT + (size_t)(nj * 32 + l31) * DM + 512 + g * 128 + ci * 32 + 4 * kh;
#pragma unroll
                    for (int q = 0; q < 4; ++q) { u32x2 o; o.x = pk2(acc[4 * q], acc[4 * q + 1]); o.y = pk2(acc[4 * q + 2], acc[4 * q + 3]); *(u32x2*)(orow + 8 * q) = o; }
                }
            }
            {
                const float* W = PIN(I_WUP) + (size_t)l * DM * NUP; const float* gpre = PIN(I_LNFPRE) + l * DM; bf16_t* WT = (bf16_t*)(ws + OFF_WUP + l * SZ_WUP);
                auto src = [=](int k, int n) { return W[(size_t)k * NUP + n] * gpre[k]; };
                auto rm = [](int n) { return n < DFF ? ((n >> 7) * 256 + (n & 127)) : (((n - DFF) >> 7) * 256 + 128 + ((n - DFF) & 127)); };
                for (int it = gwv; it < 16 * 176; it += ngw) tconv_item(scr, WT, DM, (it / 176) * 64, (it % 176) * 32, lane_, src, rm);
            }
            {
                const float* W = PIN(I_WDOWN) + (size_t)l * DFF * DM; bf16_t* WT = (bf16_t*)(ws + OFF_WDN + l * SZ_WDN);
                auto src = [=](int k, int n) { return W[(size_t)k * DM + n]; };
                for (int it = gwv; it < 44 * 32; it += ngw) tconv_item(scr, WT, DFF, (it >> 5) * 64, (it & 31) * 32, lane_, src, rid);
            }
          }
        }
        for (int row = gw; row < MTOK; row += NGW) {
            const float* xr = row < 16384 ? PIN(I_XP) + (size_t)row * DM : PIN(I_XS) + (size_t)(row - 16384) * DM;
            float s = 0.f;
#pragma unroll
            for (int j = 0; j < 2; ++j) { const f32x4 a = *(const f32x4*)(xr + 8 * lane + 512 * j), b = *(const f32x4*)(xr + 8 * lane + 512 * j + 4);
                s += (a[0] * a[0] + a[1] * a[1]) + (a[2] * a[2] + a[3] * a[3]) + (b[0] * b[0] + b[1] * b[1]) + (b[2] * b[2] + b[3] * b[3]);
                u32x4 o; o.x = pk2(a[0], a[1]); o.y = pk2(a[2], a[3]); o.z = pk2(b[0], b[1]); o.w = pk2(b[2], b[3]); *(u32x4*)(XB + (size_t)row * DM + 8 * lane + 512 * j) = o; }
            s = wave_sum(s); if (lane == 0) rstdA[row] = __builtin_amdgcn_rsqf(s * (1.0f / DM) + RMS_EPS);
        }
        for (int i = bx * 512 + tid; i < NLAYER * 2 * MTOK; i += G * 512) ssq[i] = 0.f;
        if (bx == 0) for (int i = tid; i < 4 * 257; i += 512) { const int h = i / 257, d = i % 257 - 128; tabg[i] = PIN(I_RELB)[t5_bucket(d) * 4 + h] * LOG2E; }
    }
    SEAM(0);

#pragma unroll 1
    for (int l = 0; l < NLAYER; ++l) {
        const int pb = 1 + 9 * l;
        float* ssqO = ssq + (size_t)(l * 2 + 0) * MTOK; float* ssqF = ssq + (size_t)(l * 2 + 1) * MTOK;
        if (EN(1) && IN(pb + 0)) {
            pg8::Gemm g{XB, (const bf16_t*)(ws + OFF_WIN + l * SZ_WIN), MTOK, NZ, DM}; pg8::StaticOrder S; S.init(MTOK, NZ, G, bx);
            pg8::EpiScale E{Zb, NZ, rstdA};
            pg8::gemm_phase<pg8::EpiScale, false>(lds, g, S, E);
        }
        SEAM(pb + 0);
        if (EN(2) && IN(pb + 1)) {
            float lam;
            { const int lane = otid() & 63; const float* lq = PIN(I_LAMQ) + l * 128; const float* lk = PIN(I_LAMK) + l * 128;
              const float a = wave_sum(lq[lane] * lk[lane]), b = wave_sum(lq[64 + lane] * lk[64 + lane]);
              lam = expf(a) - expf(b) + (0.8f - 0.6f * expf(-0.3f * (float)l)); }
            { const int lane_ = otid() & 63, gwv = bx * 8 + (otid() >> 6);
              for (int tb = gwv; tb < MTOK / 16; tb += G * 8) att::pool_block(Zb, A2, tb * 16, lane_); }
            __syncthreads();
            for (int u = bx; u < 1024; u += G) {
                const int kind = u >> 9, v = u & 511, i = v >> 8, b = v & 255, xc = b & 7, j = b >> 3;
                if (kind == 0) att::attn_unit(lds, Zb, A2, tabg, 16384, 16384, xc >> 1, (xc & 1) * 64 + i * 32 + j, lam);
                else att::attn_unit(lds, Zb, A2, tabg, (xc >> 2) * 8192, 8192, xc & 3, i * 32 + j, lam);
            }
        }
        SEAM(pb + 1);
        if (EN(3) && IN(pb + 2)) {
            pg8::Gemm g{A2, (const bf16_t*)(ws + OFF_WOUT + l * SZ_WOUT), MTOK, DM, DM}; pg8::StaticOrder S; S.init(MTOK, DM, G, bx);
            pg8::EpiSsq E{OB, DM, ssqO};
            pg8::gemm_phase<pg8::EpiSsq, false>(lds, g, S, E);
        }
        SEAM(pb + 2);
        if (EN(4) && IN(pb + 3)) {
            const int lane = otid() & 63, gw = bx * 8 + (otid() >> 6);
            resid_rows(XB, OB, ssqO, PIN(I_LNMPOST) + l * DM, rstdB, nullptr, false, 0, MTOK, 0, gw, NGW, lane);
        }
        SEAM(pb + 3);
#pragma unroll 1
        for (int hh = 0; hh < 2; ++hh) {
            const int T0 = hh * HALF_TOK;
            if (EN(5) && IN(pb + 4 + 2 * hh)) {
                pg8::Gemm g{XB + (size_t)(T0 - 1) * DM, (const bf16_t*)(ws + OFF_WUP + l * SZ_WUP), UP_TILES * 256, NUP, DM}; pg8::StaticOrder S; S.init(UP_TILES * 256, NUP, G, bx);
                pg8::EpiUp E{GB, rstdB, PIN(I_CONVW) + (size_t)l * 3 * NUP, PIN(I_CONVB) + (size_t)l * NUP, T0};
                pg8::gemm_phase<pg8::EpiUp, true>(lds, g, S, E);
            }
            SEAM(pb + 4 + 2 * hh);
            if (EN(6) && IN(pb + 5 + 2 * hh)) {
                pg8::Gemm g{GB, (const bf16_t*)(ws + OFF_WDN + l * SZ_WDN), HALF_TOK, DM, DFF}; pg8::StaticOrder S; S.init(HALF_TOK, DM, G, bx);
                pg8::EpiSsq E{hh == 0 ? FH0 : FH1, DM, ssqF + T0};
                pg8::gemm_phase<pg8::EpiSsq, false>(lds, g, S, E);
            }
            SEAM(pb + 5 + 2 * hh);
        }
        if (EN(7) && IN(pb + 8)) {
            const bool lastl = (l == NLAYER - 1);
            { const int lane = otid() & 63, gw = bx * 8 + (otid() >> 6);
              resid_rows(XB, FH1, ssqF, PIN(I_LNFPOST) + l * DM, rstdA, out, lastl, HALF_TOK, MTOK, HALF_TOK, gw, NGW, lane); }
            if (lastl && (P.ph_hi - P.ph_lo > 1)) { XcdBarrier xb_; xb_.bar = (unsigned*)(ws + OFF_BAR); xb_.x = xb_xcc_id(); xb_.st = (volatile LAS unsigned*)(lds + LDS_BYTES - 16); xcd_barrier(xb_); }
            { const int lane = otid() & 63, gw = bx * 8 + (otid() >> 6);
              resid_rows(XB, FH0, ssqF, PIN(I_LNFPOST) + l * DM, rstdA, out, lastl, 0, HALF_TOK, 0, gw, NGW, lane); }
        }
        SEAM(pb + 8);
    }
#undef IN
#undef SEAM
#undef ws
#undef out
#undef XB
#undef A2
#undef FH0
#undef FH1
#undef Zb
#undef OB
#undef GB
#undef rstdA
#undef rstdB
#undef ssq
#undef tabg
}

extern "C" void kernel_launch(void* const* d_in, const int* in_sizes, int n_in, void* d_out, int out_size, void* d_ws, size_t ws_size, hipStream_t stream) {
    static int grid = 0;
    if (grid == 0) {
        if (n_in != 18 || out_size != MTOK * DM || ws_size < WS_NEED) { fprintf(stderr, "kernel_launch: unexpected shapes: n_in %d out %d ws %zu (need %zu)\n", n_in, out_size, ws_size, (size_t)WS_NEED); grid = -1; return; }
        int dev = 0, cus = 0, per_cu = 0;
        (void)hipGetDevice(&dev); (void)hipDeviceGetAttribute(&cus, hipDeviceAttributeMultiprocessorCount, dev);
        if (hipFuncSetAttribute((const void*)fwd_megakernel, hipFuncAttributeMaxDynamicSharedMemorySize, LDS_BYTES) != hipSuccess) { fprintf(stderr, "kernel_launch: hipFuncSetAttribute failed\n"); grid = -1; return; }
        (void)hipOccupancyMaxActiveBlocksPerMultiprocessor(&per_cu, (const void*)fwd_megakernel, 512, LDS_BYTES);
        (void)hipGetLastError();
        if (per_cu < 1) per_cu = 1;
        grid = cus * 1;
        if (grid <= 0) grid = 256;
    }
    if (grid < 0) return;
    (void)hipMemsetAsync((char*)d_ws + OFF_BAR, 0, 3456 * 4, stream);
    Params p{};
    for (int i = 0; i < 18; ++i) p.in[i] = (const float*)d_in[i];
    p.out = (float*)d_out; p.ws = (unsigned char*)d_ws;
#if MK_MULTI
    for (int ph = 0; ph < NPHASE; ++ph) { p.ph_lo = ph; p.ph_hi = ph + 1; hipLaunchKernelGGL(fwd_megakernel, dim3(grid), dim3(512), LDS_BYTES, stream, p); }
#else
    p.ph_lo = 0; p.ph_hi = NPHASE;
    void* args[] = {&p};
    hipError_t e = hipLaunchCooperativeKernel((const void*)fwd_megakernel, dim3(grid), dim3(512), args, LDS_BYTES, stream);
    if (e != hipSuccess) fprintf(stderr, "cooperative launch failed: %s (grid %d)\n", hipGetErrorString(e), grid);
#endif
}
```

```cpp
#include <hip/hip_runtime.h>
#include <hip/hip_cooperative_groups.h>
#include <cstdio>
#include <cstdint>
namespace cg = cooperative_groups;

#ifndef MK_MULTI
#define MK_MULTI 0
#endif

#define LAS __attribute__((address_space(3)))
typedef unsigned short bf16_t;
typedef short bf16x8 __attribute__((ext_vector_type(8)));
typedef short s16x4 __attribute__((ext_vector_type(4)));
typedef float f32x4 __attribute__((ext_vector_type(4)));
typedef float f32x16 __attribute__((ext_vector_type(16)));
typedef unsigned u32x4 __attribute__((ext_vector_type(4)));
typedef unsigned u32x2 __attribute__((ext_vector_type(2)));

constexpr int MTOK = 32768, DM = 1024, NZ = 2048, DFF = 2816, NUP = 5632, NLAYER = 2;
constexpr int HALF_TOK = 16384, UP_TILES = 66;
constexpr float RMS_EPS = 1e-6f;
constexpr float QSCALE = 0.125f * 1.4426950408889634f;
constexpr float LOG2E = 1.4426950408889634f;

constexpr size_t OFF_WIN = 0, SZ_WIN = (size_t)NZ * DM * 2;
constexpr size_t OFF_WOUT = OFF_WIN + NLAYER * SZ_WIN, SZ_WOUT = (size_t)DM * DM * 2;
constexpr size_t OFF_WUP = OFF_WOUT + NLAYER * SZ_WOUT, SZ_WUP = (size_t)NUP * DM * 2;
constexpr size_t OFF_WDN = OFF_WUP + NLAYER * SZ_WUP, SZ_WDN = (size_t)DM * DFF * 2;
constexpr size_t OFF_SMALL = OFF_WDN + NLAYER * SZ_WDN;
constexpr size_t OFF_RSTD_A = OFF_SMALL, OFF_RSTD_B = OFF_RSTD_A + MTOK * 4;
constexpr size_t OFF_SSQ = OFF_RSTD_B + MTOK * 4;
constexpr size_t OFF_TAB = OFF_SSQ + (size_t)NLAYER * 2 * MTOK * 4;
constexpr size_t OFF_BAR = OFF_TAB + 8192;
constexpr size_t OFF_XB = 50331648 + 4096;
constexpr size_t OFF_Z = 125829120;
constexpr size_t WS_NEED = OFF_Z + (size_t)MTOK * NZ * 2;
constexpr size_t OFF_FH0 = (size_t)HALF_TOK * DFF * 2;
static_assert(OFF_FH0 + (size_t)HALF_TOK * DM * 2 <= (size_t)MTOK * NZ * 2, "F half 0 fits behind G");
static_assert(OFF_BAR + 3456 * 4 <= 50331648, "small region");
static_assert(OFF_XB + (size_t)(MTOK + 512) * DM * 2 <= OFF_Z, "xb region");

constexpr int LDS_BYTES = 149504;

__device__ __forceinline__ unsigned pk2(float lo, float hi) {
    typedef float f32x2_t __attribute__((ext_vector_type(2))); typedef __bf16 bf16x2_t __attribute__((ext_vector_type(2)));
    f32x2_t v = {lo, hi}; bf16x2_t b = __builtin_convertvector(v, bf16x2_t); return __builtin_bit_cast(unsigned, b);
}
__device__ __forceinline__ float bflo(unsigned w) { return __uint_as_float(w << 16); }
__device__ __forceinline__ float bfhi(unsigned w) { return __uint_as_float(w & 0xffff0000u); }
__device__ __forceinline__ int otid() { int t = threadIdx.x; asm volatile("" : "+v"(t)); return t; }
__device__ __forceinline__ float wave_sum(float v) {
#pragma unroll
    for (int o = 1; o < 64; o <<= 1) v += __shfl_xor(v, o);
    return v;
}

namespace pg8 {
constexpr int BM = 256, BK = 64, HALF = 128, HTB = HALF * BK * 2, STAGE_BYTES = 8 * HTB, NXCD = 8, WGM = 8;
__host__ __device__ __forceinline__ int lds_byte(int r, int c) { const int st = (r >> 4) * 2 + (c >> 5), rr = r & 15, cc = c & 31, ob = rr * 64 + cc * 2; return st * 1024 + (ob ^ (((ob >> 9) & 1) << 5)); }
__host__ __device__ __forceinline__ void stage_rc(int b, int& R, int& C) { const int st = b / 1024, sb = b % 1024, swz = sb ^ (((sb >> 9) & 1) << 5); R = (st >> 1) * 16 + swz / 64; C = (st & 1) * 32 + (swz % 64) / 2; }
__host__ __device__ __forceinline__ int perm32(int rho) { const int n = rho >> 4, i = rho & 15; return 8 * (i >> 2) + 4 * n + (i & 3); }

struct Unit { int pm, pn; };
struct Gemm { const bf16_t* A; const bf16_t* Bt; int M, N, K; };

struct StaticOrder {
    int nM, nN, nwg, G, c;
    __device__ void init(int M, int N, int G_, int c_) { nM = M / BM; nN = N / BM; nwg = nM * nN; G = G_; c = c_; }
    __device__ bool next(int i, Unit& u) const {
        const long L = (long)i * G + c; if (L >= nwg) return false;
        int wgid = (int)L; { const int q = nwg / NXCD, r = nwg % NXCD, xcd = wgid % NXCD, off = wgid / NXCD; wgid = (xcd < r ? xcd * (q + 1) : r * (q + 1) + (xcd - r) * q) + off; }
        const int nig = WGM * nN, gid = wgid / nig, fm = gid * WGM, gsz = (nM - fm) < WGM ? (nM - fm) : WGM;
        u.pm = fm + ((wgid % nig) % gsz); u.pn = (wgid % nig) / gsz; return true;
    }
};

struct EpiScale {
    static constexpr bool PERM = true;
    bf16_t* O; int ldc; const float* rs;
    __device__ __forceinline__ void operator()(const f32x4 (&acc)[2][2][4][2], const Unit& u, int wr, int wc, int fr, int fq) const {
        const int row0 = u.pm * BM + wr * 64 + fr, col0 = u.pn * BM + wc * 32 + 8 * fq;
#pragma unroll
        for (int ai = 0; ai < 2; ++ai)
#pragma unroll
            for (int m = 0; m < 4; ++m) {
                const int row = row0 + ai * HALF + m * 16; const float s = rs[row]; bf16_t* rowp = O + (size_t)row * ldc + col0;
#pragma unroll
                for (int bj = 0; bj < 2; ++bj) { const f32x4 v0 = acc[ai][bj][m][0] * s, v1 = acc[ai][bj][m][1] * s; u32x4 w;
                    w.x = pk2(v0[0], v0[1]); w.y = pk2(v0[2], v0[3]); w.z = pk2(v1[0], v1[1]); w.w = pk2(v1[2], v1[3]); *(u32x4*)(rowp + bj * HALF) = w; }
            }
    }
};
struct EpiSsq {
    static constexpr bool PERM = true;
    bf16_t* O; int ldc; float* ssq;
    __device__ __forceinline__ void operator()(const f32x4 (&acc)[2][2][4][2], const Unit& u, int wr, int wc, int fr, int fq) const {
        const int row0 = u.pm * BM + wr * 64 + fr, col0 = u.pn * BM + wc * 32 + 8 * fq;
#pragma unroll
        for (int ai = 0; ai < 2; ++ai)
#pragma unroll
            for (int m = 0; m < 4; ++m) {
                const int row = row0 + ai * HALF + m * 16; bf16_t* rowp = O + (size_t)row * ldc + col0; float q = 0.f;
#pragma unroll
                for (int bj = 0; bj < 2; ++bj) { const f32x4 v0 = acc[ai][bj][m][0], v1 = acc[ai][bj][m][1]; u32x4 w;
                    q += (v0[0] * v0[0] + v0[1] * v0[1]) + (v0[2] * v0[2] + v0[3] * v0[3]) + (v1[0] * v1[0] + v1[1] * v1[1]) + (v1[2] * v1[2] + v1[3] * v1[3]);
                    w.x = pk2(v0[0], v0[1]); w.y = pk2(v0[2], v0[3]); w.z = pk2(v1[0], v1[1]); w.w = pk2(v1[2], v1[3]); *(u32x4*)(rowp + bj * HALF) = w; }
                q += __shfl_xor(q, 16); q += __shfl_xor(q, 32);
                if (fq == 0) atomicAdd(ssq + row, q);
            }
    }
};
__device__ __forceinline__ float gelu_tanh(float x) {
    const float u = x * (1.0f + 0.044715f * x * x);
    const float e = __builtin_amdgcn_exp2f(-2.302208198f * u);
    return x * __builtin_amdgcn_rcpf(1.0f + e);
}
struct EpiUp {
    static constexpr bool PERM = true;
    bf16_t* G; const float* rstd; const float* cw; const float* cb; int T0;
    __device__ __forceinline__ void operator()(const f32x4 (&acc)[2][2][4][2], const Unit& u, int wr, int wc, int fr, int fq) const {
        const int grow0 = 252 * u.pm + 126 * wr - 1 + 8 * fr;
        const int cg0 = 128 * u.pn + 32 * wc + 8 * fq;
        float rs[8]; bool pz[8], nz[8];
#pragma unroll
        for (int i = 0; i < 8; ++i) { const int t = T0 + grow0 + i; const int tc = t < 0 ? 0 : (t > MTOK - 1 ? MTOK - 1 : t); rs[i] = rstd[tc];
            pz[i] = ((t & 8191) == 0) && (t != 24576); nz[i] = (((t + 1) & 8191) == 0) && (t + 1 != 24576); }
#pragma unroll
        for (int n = 0; n < 2; ++n) {
            float res[8][4];
#pragma unroll
            for (int j = 0; j < 4; ++j) {
                const int cg = cg0 + 4 * n + j;
                const float gw0 = cw[cg], gw1 = cw[NUP + cg], gw2 = cw[2 * NUP + cg], gb = cb[cg];
                const float vw0 = cw[DFF + cg], vw1 = cw[NUP + DFF + cg], vw2 = cw[2 * NUP + DFF + cg], vb = cb[DFF + cg];
                float xg[8], xv[8];
#pragma unroll
                for (int i = 0; i < 8; ++i) { xg[i] = acc[i >> 2][0][i & 3][n][j] * rs[i]; xv[i] = acc[i >> 2][1][i & 3][n][j] * rs[i]; }
                const float gp = __builtin_bit_cast(float, __builtin_amdgcn_update_dpp(0, __builtin_bit_cast(int, xg[7]), 0x111, 0xf, 0xf, false));
                const float gn = __builtin_bit_cast(float, __builtin_amdgcn_update_dpp(0, __builtin_bit_cast(int, xg[0]), 0x101, 0xf, 0xf, false));
                const float vp = __builtin_bit_cast(float, __builtin_amdgcn_update_dpp(0, __builtin_bit_cast(int, xv[7]), 0x111, 0xf, 0xf, false));
                const float vn = __builtin_bit_cast(float, __builtin_amdgcn_update_dpp(0, __builtin_bit_cast(int, xv[0]), 0x101, 0xf, 0xf, false));
#pragma unroll
                for (int i = 0; i < 8; ++i) {
                    float pg = i > 0 ? xg[i - 1] : gp, ng = i < 7 ? xg[i + 1] : gn, pv = i > 0 ? xv[i - 1] : vp, nv = i < 7 ? xv[i + 1] : vn;
                    if (pz[i]) { pg = 0.f; pv = 0.f; } if (nz[i]) { ng = 0.f; nv = 0.f; }
                    const float cgv = gw0 * pg + gw1 * xg[i] + gw2 * ng + gb;
                    const float cvv = vw0 * pv + vw1 * xv[i] + vw2 * nv + vb;
                    res[i][j] = gelu_tanh(cgv) * cvv;
                }
            }
#pragma unroll
            for (int i = 0; i < 8; ++i) { const int s = 8 * fr + i, grow = grow0 + i;
                if (s >= 1 && s <= 126 && grow < HALF_TOK) { u32x2 w; w.x = pk2(res[i][0], res[i][1]); w.y = pk2(res[i][2], res[i][3]); *(u32x2*)(G + (size_t)grow * DFF + cg0 + 4 * n) = w; } }
            __builtin_amdgcn_sched_barrier(0);
        }
    }
};

template <class Epi, bool UPMODE>
__device__ __forceinline__ void gemm_phase(LAS unsigned char* lds, const Gemm g, const StaticOrder& S, const Epi& E) {
    const int tid = otid(), wid = __builtin_amdgcn_readfirstlane(tid >> 6), lane = tid & 63, wr = wid >> 2, wc = wid & 3, fr = lane & 15, fq = lane >> 4;
    const int K = g.K, nt = K / BK;
    unsigned voffA[2], voffB[2];
#pragma unroll
    for (int i = 0; i < 2; ++i) { int R, C; stage_rc(tid * 16 + i * 8192, R, C); const int Rb = Epi::PERM ? ((R & ~31) + perm32(R & 31)) : R;
        const int Ra = UPMODE ? (126 * (R >> 6) + 8 * (R & 15) + ((R >> 4) & 3)) : R;
        voffA[i] = (unsigned)(Ra * K + C) * 2u; voffB[i] = (unsigned)(Rb * K + C) * 2u; }
    const size_t kstep = (size_t)(BK * 2);
    const size_t hstepB = (size_t)HALF * K * 2, tstepB = 2 * hstepB;
    const size_t hstepA = UPMODE ? (size_t)4 * K * 2 : hstepB, tstepA = UPMODE ? (size_t)252 * K * 2 : tstepB;
    const unsigned ldsw = (unsigned)wid * 1024u;
    const int aoff = lds_byte(wr * 64 + fr, fq * 8), boff = lds_byte(wc * 32 + fr, fq * 8);
#define PG8_SA(b, h) (((b) * 2 + (h)) * HTB)
#define PG8_SB(b, h) ((4 + (b) * 2 + (h)) * HTB)
#define PG8_STAGE(bufoff, gbase, voff) do { _Pragma("unroll") for (int _i = 0; _i < 2; ++_i) \
        __builtin_amdgcn_global_load_lds((const unsigned*)((const char*)(gbase) + (voff)[_i]), (LAS unsigned*)(lds + (bufoff) + ldsw + _i * 8192), 16, 0, 0); } while (0)
#define PG8_LDA(dst, b, h) do { _Pragma("unroll") for (int m = 0; m < 4; ++m) _Pragma("unroll") for (int k = 0; k < 2; ++k) dst[m][k] = *(const LAS bf16x8*)(lds + PG8_SA(b, h) + aoff + m * 2048 + k * 1024); } while (0)
#define PG8_LDB(dst, b, h) do { _Pragma("unroll") for (int n = 0; n < 2; ++n) _Pragma("unroll") for (int k = 0; k < 2; ++k) dst[n][k] = *(const LAS bf16x8*)(lds + PG8_SB(b, h) + boff + n * 2048 + k * 1024); } while (0)
#define PG8_MMA(ai, bj, At, Bt) do { __builtin_amdgcn_s_setprio(1); _Pragma("unroll") for (int m = 0; m < 4; ++m) _Pragma("unroll") for (int n = 0; n < 2; ++n) _Pragma("unroll") for (int k = 0; k < 2; ++k) \
        acc[ai][bj][m][n] = __builtin_amdgcn_mfma_f32_16x16x32_bf16(Bt[n][k], At[m][k], acc[ai][bj][m][n], 0, 0, 0); __builtin_amdgcn_s_setprio(0); } while (0)
#define PG8_WAIT_V(n) asm volatile("s_waitcnt vmcnt(" #n ")" ::: "memory")
#define PG8_WAIT_L(n) asm volatile("s_waitcnt lgkmcnt(" #n ")" ::: "memory")
#define PG8_BAR __builtin_amdgcn_s_barrier()
#define PG8_SCHED __builtin_amdgcn_sched_barrier(0)
    Unit cur, nxt; int ui = 0;
    if (!S.next(0, cur)) return;
    f32x4 acc[2][2][4][2];
#pragma unroll
    for (int a = 0; a < 2; ++a)
#pragma unroll
        for (int b = 0; b < 2; ++b)
#pragma unroll
            for (int m = 0; m < 4; ++m)
#pragma unroll
                for (int n = 0; n < 2; ++n) acc[a][b][m][n] = (f32x4){0.f, 0.f, 0.f, 0.f};
    bf16x8 At[4][2], B0[2][2], B1[2][2];
    const char* cA = (const char*)g.A + (size_t)cur.pm * tstepA; const char* cB = (const char*)g.Bt + (size_t)cur.pn * tstepB;
    PG8_STAGE(PG8_SB(0, 0), cB, voffB); PG8_STAGE(PG8_SB(0, 1), cB + hstepB, voffB); PG8_STAGE(PG8_SA(0, 0), cA, voffA); PG8_STAGE(PG8_SA(0, 1), cA + hstepA, voffA);
    if (wr == 1) PG8_BAR;
    PG8_WAIT_V(2); PG8_BAR;
    PG8_STAGE(PG8_SB(1, 0), cB + kstep, voffB); PG8_STAGE(PG8_SA(1, 0), cA + kstep, voffA); PG8_STAGE(PG8_SB(1, 1), cB + hstepB + kstep, voffB);
    PG8_WAIT_V(6); PG8_BAR;
    for (;;) {
        const bool has_next = S.next(ui + 1, nxt);
        const char* nA = has_next ? (const char*)g.A + (size_t)nxt.pm * tstepA : cA; const char* nB = has_next ? (const char*)g.Bt + (size_t)nxt.pn * tstepB : cB;
        for (int t = 0; t < nt; t += 2) {
            const bool last = (t == nt - 2);
            const char* a1 = cA + (size_t)(t + 1) * kstep;
            const char* a2 = last ? nA : cA + (size_t)(t + 2) * kstep; const char* b2 = last ? nB : cB + (size_t)(t + 2) * kstep;
            const char* a3 = a2 + kstep; const char* b3 = b2 + kstep;
            PG8_LDB(B0, 0, 0); PG8_LDB(B1, 0, 1); PG8_SCHED; PG8_LDA(At, 0, 0); PG8_STAGE(PG8_SA(1, 1), a1 + hstepA, voffA);
            PG8_WAIT_V(8); PG8_WAIT_L(0); PG8_BAR; PG8_MMA(0, 0, At, B0); PG8_MMA(0, 1, At, B1); PG8_BAR; PG8_SCHED;
            PG8_LDA(At, 0, 1); PG8_STAGE(PG8_SB(0, 0), b2, voffB); PG8_STAGE(PG8_SB(0, 1), b2 + hstepB, voffB); PG8_STAGE(PG8_SA(0, 0), a2, voffA);
            PG8_WAIT_V(8); PG8_WAIT_L(0); PG8_BAR; PG8_MMA(1, 0, At, B0); PG8_MMA(1, 1, At, B1); PG8_BAR; PG8_SCHED;
            PG8_LDB(B0, 1, 0); PG8_LDB(B1, 1, 1); PG8_SCHED; PG8_LDA(At, 1, 0); PG8_STAGE(PG8_SA(0, 1), a2 + hstepA, voffA);
            PG8_WAIT_V(8); PG8_WAIT_L(0); PG8_BAR; PG8_MMA(0, 0, At, B0); PG8_MMA(0, 1, At, B1); PG8_BAR; PG8_SCHED;
            PG8_LDA(At, 1, 1); PG8_STAGE(PG8_SB(1, 0), b3, voffB); PG8_STAGE(PG8_SB(1, 1), b3 + hstepB, voffB); PG8_STAGE(PG8_SA(1, 0), a3, voffA);
            PG8_WAIT_V(8); PG8_WAIT_L(0); PG8_BAR; PG8_MMA(1, 0, At, B0); PG8_MMA(1, 1, At, B1); PG8_BAR; PG8_SCHED;
        }
        if (wr == 0) PG8_BAR;
        E(acc, cur, wr, wc, fr, fq);
        if (!has_next) break;
#pragma unroll
        for (int a = 0; a < 2; ++a)
#pragma unroll
            for (int b = 0; b < 2; ++b)
#pragma unroll
                for (int m = 0; m < 4; ++m)
#pragma unroll
                    for (int n = 0; n < 2; ++n) acc[a][b][m][n] = (f32x4){0.f, 0.f, 0.f, 0.f};
        cur = nxt; cA = nA; cB = nB; ++ui;
        if (wr == 1) PG8_BAR;
    }
    PG8_WAIT_V(0);
    PG8_BAR;
#undef PG8_SA
#undef PG8_SB
#undef PG8_STAGE
#undef PG8_LDA
#undef PG8_LDB
#undef PG8_MMA
#undef PG8_WAIT_V
#undef PG8_WAIT_L
#undef PG8_BAR
#undef PG8_SCHED
}
}

namespace att {
constexpr int KT = 64 * 256, VT = 64 * 256;
constexpr int NST = 3, OFF_K = 0, OFF_V = NST * KT, OFF_SCR = NST * KT + NST * VT, OFF_TAB = OFF_SCR + 8 * 256, LDS_USED = OFF_TAB + 2048;
static_assert(LDS_USED <= LDS_BYTES, "attention LDS");
constexpr float MNEG = -1.0e30f, THR = 8.0f;

__device__ __forceinline__ bf16x8 pack8(const f32x16& p, int b) {
    u32x4 w; w.x = pk2(p[b + 0], p[b + 1]); w.y = pk2(p[b + 2], p[b + 3]); w.z = pk2(p[b + 4], p[b + 5]); w.w = pk2(p[b + 6], p[b + 7]);
    return __builtin_bit_cast(bf16x8, w);
}
typedef float f32x2 __attribute__((ext_vector_type(2)));
__device__ __forceinline__ void glds16(const void* gbase  , unsigned voff, unsigned lds_dst) { unsigned keep;
    asm volatile("s_mov_b32 %0, m0\n\ts_mov_b32 m0, %3\n\ts_nop 0\n\tglobal_load_lds_dwordx4 %1, %2\n\ts_mov_b32 m0, %0" : "=&s"(keep) : "v"(voff), "s"(gbase), "s"(lds_dst) : "memory"); }
__device__ __forceinline__ float max16f(const f32x16& p) { float a, b;
    asm("v_max3_f32 %0, %2, %3, %4\n\tv_max3_f32 %1, %5, %6, %7\n\tv_max3_f32 %0, %0, %8, %9\n\tv_max3_f32 %1, %1, %10, %11\n\tv_max3_f32 %0, %0, %12, %13\n\tv_max3_f32 %1, %1, %14, %15\n\tv_max3_f32 %0, %0, %16, %17\n\tv_max_f32_e32 %0, %0, %1"
        : "=&v"(a), "=&v"(b) : "v"(p[0]), "v"(p[1]), "v"(p[2]), "v"(p[3]), "v"(p[4]), "v"(p[5]), "v"(p[6]), "v"(p[7]), "v"(p[8]), "v"(p[9]), "v"(p[10]), "v"(p[11]), "v"(p[12]), "v"(p[13]), "v"(p[14]), "v"(p[15]));
    return a; }
__device__ __forceinline__ float max3f(float a, float b, float c) { float r; asm("v_max3_f32 %0, %1, %2, %3" : "=v"(r) : "v"(a), "v"(b), "v"(c)); return r; }
__device__ __forceinline__ float max2f(float a, float b) { float r; asm("v_max_f32_e32 %0, %1, %2" : "=v"(r) : "v"(a), "v"(b)); return r; }
typedef short v4i16_t __attribute__((ext_vector_type(4)));
__device__ __forceinline__ s16x4 vtr(const LAS unsigned char* p) { return __builtin_bit_cast(s16x4, __builtin_amdgcn_ds_read_tr16_b64_v4i16((LAS v4i16_t*)p)); }

__device__ __forceinline__ void attn_unit(LAS unsigned char* lds, const bf16_t* Z, bf16_t* A2, const float* tabg, int seq_base, int S, int h, int qb, float lam) {
    const int tid = otid(), w = __builtin_amdgcn_readfirstlane(tid >> 6), lane = tid & 63, r32 = lane & 31, hi = lane >> 5, g4 = lane >> 4, i16 = lane & 15;
    const int rg = w & 3, m = w >> 2;
    LAS unsigned char* Kb = lds + OFF_K; LAS unsigned char* Vb = lds + OFF_V;
    LAS float* scr = (LAS float*)(lds + OFF_SCR) + w * 64;
    LAS float* tab = (LAS float*)(lds + OFF_TAB);
    for (int i = tid; i < 449; i += 512) { int d = i - 224; d = d < -128 ? -128 : (d > 128 ? 128 : d); tab[i] = tabg[h * 257 + d + 128]; }
    const int qlo = qb * 128 + rg * 32;
    bf16x8 qf[4];
    { const bf16_t* qrow = Z + (size_t)(seq_base + qlo + r32) * NZ + h * 128 + m * 64 + 8 * hi;
#pragma unroll
      for (int ds = 0; ds < 4; ++ds) qf[ds] = *(const bf16x8*)(qrow + 16 * ds); }
    const char* kvbase = (const char*)(Z + (size_t)seq_base * NZ + h * 128);
    unsigned koff[2], voff[2];
#pragma unroll
    for (int i = 0; i < 2; ++i) { const int row = (i * 8 + w) * 4 + (lane >> 4), cp = lane & 15;
        koff[i] = (unsigned)(row * NZ + 512 + ((cp ^ (row & 15)) << 3)) * 2u; voff[i] = (unsigned)(row * NZ + 1024 + ((cp ^ (4 * (row & 3))) << 3)) * 2u; }
    const unsigned kb_u = (unsigned)(size_t)Kb + (unsigned)w * 1024u, vb_u = (unsigned)(size_t)Vb + (unsigned)w * 1024u;
#define ATT_STAGE(t_, buf_) do { const char* tb_ = kvbase + (size_t)(t_) * 64 * NZ * 2; _Pragma("unroll") for (int i_ = 0; i_ < 2; ++i_) { \
        glds16(tb_, koff[i_], (unsigned)__builtin_amdgcn_readfirstlane(kb_u + (buf_) * KT + i_ * 8192)); \
        glds16(tb_, voff[i_], (unsigned)__builtin_amdgcn_readfirstlane(vb_u + (buf_) * VT + i_ * 8192)); } } while (0)
    ATT_STAGE(0, 0); ATT_STAGE(1, 1);
    asm volatile("s_waitcnt vmcnt(4) lgkmcnt(0)" ::: "memory"); __builtin_amdgcn_s_barrier(); asm volatile("" ::: "memory");
#pragma unroll
    for (int ds = 0; ds < 4; ++ds) asm volatile("" : "+v"(qf[ds]));
    const float tabL = tab[0], tabR = tab[448];
    f32x16 O[4];
#pragma unroll
    for (int d = 0; d < 4; ++d)
#pragma unroll
        for (int r = 0; r < 16; ++r) O[d][r] = 0.f;
    float mu = 0.f; f32x2 ls2 = {0.f, 0.f};
    f32x16 cblk; float coff_cur = __builtin_nanf("");
#pragma unroll
    for (int r = 0; r < 16; ++r) cblk[r] = 0.f;
    const int NT = S >> 6;
    const unsigned kfo = r32 * 256 + ((unsigned)((m * 8 + hi) ^ (r32 & 15)) << 4);
    const unsigned vj = (i16 >> 2) & 3;
    const unsigned vfo = (4 * hi + (i16 >> 2)) * 256 + (vj << 6) + 32 * (g4 & 1) + 8 * (i16 & 3);
    int bc = 0, bn = 2;
    for (int t = 0; t < NT; ++t) {
        if (t + 2 < NT) ATT_STAGE(t + 2, bn);
        const LAS unsigned char* Kt = Kb + bc * KT; const LAS unsigned char* Vt = Vb + bc * VT;
        const int kv0 = t * 64;
        bool near = true; float cc = 0.f;
        if (kv0 - (qlo + 31) >= 128) { near = false; cc = tabR; } else if (qlo - (kv0 + 63) >= 128) { near = false; cc = tabL; }
        { const float coff = cc - mu;
          if (__any(!(coff == coff_cur))) { coff_cur = coff;
#pragma unroll
              for (int r = 0; r < 16; ++r) cblk[r] = coff;
              asm volatile("" : "+v"(cblk)); } }
        f32x16 p0, p1;
        {
            bf16x8 kf[8];
#pragma unroll
            for (int ds = 0; ds < 4; ++ds) { kf[2 * ds] = *(const LAS bf16x8*)(Kt + (kfo ^ (unsigned)(ds << 5))); kf[2 * ds + 1] = *(const LAS bf16x8*)(Kt + 32 * 256 + (kfo ^ (unsigned)(ds << 5))); }
            __builtin_amdgcn_sched_barrier(0);
            p0 = __builtin_amdgcn_mfma_f32_32x32x16_bf16(kf[0], qf[0], cblk, 0, 0, 0);
            p1 = __builtin_amdgcn_mfma_f32_32x32x16_bf16(kf[1], qf[0], cblk, 0, 0, 0);
#pragma unroll
            for (int ds = 1; ds < 4; ++ds) {
                p0 = __builtin_amdgcn_mfma_f32_32x32x16_bf16(kf[2 * ds], qf[ds], p0, 0, 0, 0);
                p1 = __builtin_amdgcn_mfma_f32_32x32x16_bf16(kf[2 * ds + 1], qf[ds], p1, 0, 0, 0);
            }
        }
#define VTR(dst, addr, off) asm volatile("ds_read_b64_tr_b16 %0, %1 offset:%2" : "=v"(dst) : "v"(addr), "i"(off) : "memory")
#define VREADS1(arr, d_) do { const unsigned ad_ = vbase ^ (unsigned)((d_) << 6); __builtin_amdgcn_sched_barrier(0); \
        _Pragma("unroll") for (int ks_ = 0; ks_ < 4; ++ks_) { VTR(arr[ks_ * 2], ad_, ks_ * 4096); VTR(arr[ks_ * 2 + 1], ad_, ks_ * 4096 + 2048); } __builtin_amdgcn_sched_barrier(0); } while (0)
#define PV1(arr, d_) do { _Pragma("unroll") for (int ks_ = 0; ks_ < 4; ++ks_) { const s16x4 lo_ = arr[ks_ * 2], hh_ = arr[ks_ * 2 + 1]; \
        const bf16x8 bv_ = (bf16x8){lo_[0], lo_[1], lo_[2], lo_[3], hh_[0], hh_[1], hh_[2], hh_[3]}; \
        O[d_] = __builtin_amdgcn_mfma_f32_32x32x16_bf16(pa[ks_], bv_, O[d_], 0, 0, 0); } __builtin_amdgcn_sched_barrier(0); } while (0)
#define LGKM0() do { __builtin_amdgcn_sched_barrier(0); asm volatile("s_waitcnt lgkmcnt(0)" ::: "memory"); __builtin_amdgcn_sched_barrier(0); } while (0)
        const unsigned vbase = (unsigned)(size_t)Vt + vfo;
        s16x4 va[8], vb[8];
        VREADS1(va, 0);
        if (near) {
            const LAS float* tp = tab + (kv0 + 4 * hi - (qlo + r32) + 224);
#pragma unroll
            for (int r = 0; r < 16; ++r) { p0[r] += tp[(r & 3) + 8 * (r >> 2)]; p1[r] += tp[32 + (r & 3) + 8 * (r >> 2)]; }
        }
        float mx = max2f(max16f(p0), max16f(p1));
        const bool first = (t == 0);
        if (first || __any(mx > THR)) {
            { auto rr = __builtin_amdgcn_permlane32_swap(__float_as_uint(mx), __float_as_uint(mx), false, false); mx = max2f(__uint_as_float(rr[0]), __uint_as_float(rr[1])); }
            const float delta = first ? mx : fmaxf(mx, 0.f);
            const float alpha = first ? 1.0f : __builtin_amdgcn_exp2f(-delta);
            mu += delta; ls2 *= alpha;
            if (!first) {
                asm volatile("" ::: "memory");
                scr[r32] = alpha;
                asm volatile("s_waitcnt lgkmcnt(0)" ::: "memory");
#pragma unroll
                for (int g = 0; g < 4; ++g) { const f32x4 a4 = *(const LAS f32x4*)(scr + 8 * g + 4 * hi);
#pragma unroll
                    for (int d = 0; d < 4; ++d) { O[d][4 * g + 0] *= a4[0]; O[d][4 * g + 1] *= a4[1]; O[d][4 * g + 2] *= a4[2]; O[d][4 * g + 3] *= a4[3]; } }
                asm volatile("s_waitcnt lgkmcnt(0)" ::: "memory");
            }
#pragma unroll
            for (int r = 0; r < 16; ++r) { p0[r] -= delta; p1[r] -= delta; }
            asm volatile("" : "+v"(p0), "+v"(p1));
        }
#pragma unroll
        for (int r = 0; r < 16; ++r) { p0[r] = __builtin_amdgcn_exp2f(p0[r]); p1[r] = __builtin_amdgcn_exp2f(p1[r]); }
#pragma unroll
        for (int r = 0; r < 16; r += 2) { ls2 += (f32x2){p0[r], p0[r + 1]}; ls2 += (f32x2){p1[r], p1[r + 1]}; }
        bf16x8 pa[4]; pa[0] = pack8(p0, 0); pa[1] = pack8(p0, 8); pa[2] = pack8(p1, 0); pa[3] = pack8(p1, 8);
        LGKM0(); VREADS1(vb, 1); PV1(va, 0); LGKM0(); VREADS1(va, 2); PV1(vb, 1); LGKM0(); VREADS1(vb, 3); PV1(va, 2); LGKM0(); PV1(vb, 3);
#undef VTR
#undef VREADS1
#undef PV1
#undef LGKM0
        if (t + 2 < NT) asm volatile("s_waitcnt vmcnt(4) lgkmcnt(0)" ::: "memory"); else asm volatile("s_waitcnt vmcnt(0) lgkmcnt(0)" ::: "memory");
        __builtin_amdgcn_s_barrier(); asm volatile("" ::: "memory");
        bc = (bc == NST - 1) ? 0 : bc + 1; bn = (bn == NST - 1) ? 0 : bn + 1;
    }
    const float ls = ls2[0] + ls2[1];
#undef ATT_STAGE
    int r32e = r32, hie = hi; asm volatile("" : "+v"(r32e), "+v"(hie));
    const float lt = ls + __shfl_xor(ls, 32);
    asm volatile("" ::: "memory");
    scr[r32e] = (m == 0 ? 1.0f : lam) / lt;
    asm volatile("s_waitcnt lgkmcnt(0)" ::: "memory");
#pragma unroll
    for (int g = 0; g < 4; ++g) { const f32x4 c0 = *(const LAS f32x4*)(scr + 8 * g + 4 * hie);
#pragma unroll
        for (int k = 0; k < 4; ++k)
#pragma unroll
            for (int d = 0; d < 4; ++d) O[d][4 * g + k] *= c0[k]; }
    LAS float* X = (LAS float*)lds + (size_t)rg * 4096 + lane;
    if (m == 1) {
#pragma unroll
        for (int d = 0; d < 4; ++d)
#pragma unroll
            for (int r = 0; r < 16; ++r) X[(d * 16 + r) * 64] = O[d][r];
    }
    __syncthreads();
    if (m == 0) {
        float ss[16];
#pragma unroll
        for (int r = 0; r < 16; ++r) { float q = 0.f;
#pragma unroll
            for (int d = 0; d < 4; ++d) { const float o = O[d][r] - X[(d * 16 + r) * 64]; O[d][r] = o; q += o * o; }
            ss[r] = q; }
#pragma unroll
        for (int r = 0; r < 16; ++r) { float q = ss[r];
#pragma unroll
            for (int o = 1; o < 32; o <<= 1) q += __shfl_xor(q, o);
            ss[r] = __builtin_amdgcn_rsqf(q * (1.0f / 128.0f) + RMS_EPS); }
#pragma unroll
        for (int r = 0; r < 16; ++r) { const int q = (r & 3) + 8 * (r >> 2) + 4 * hie;
            bf16_t* orow = A2 + (size_t)(seq_base + qlo + q) * DM + h * 128 + r32e;
#pragma unroll
            for (int d = 0; d < 4; ++d) orow[d * 32] = (bf16_t)(pk2(O[d][r] * ss[r], 0.f) & 0xffffu); }
    }
    __syncthreads();
}

__device__ __forceinline__ void unpack8(const u32x4 v, float* a) { a[0] = bflo(v.x); a[1] = bfhi(v.x); a[2] = bflo(v.y); a[3] = bfhi(v.y); a[4] = bflo(v.z); a[5] = bfhi(v.z); a[6] = bflo(v.w); a[7] = bfhi(v.w); }
__device__ __forceinline__ void pool_block(const bf16_t* Z, bf16_t* A2, int row0, int lane) {
    int sb, S; if (row0 < 8192) { sb = 0; S = 8192; } else if (row0 < 16384) { sb = 8192; S = 8192; } else { sb = 16384; S = 16384; }
    const int t0 = row0 - sb, g = lane >> 4, hw = 1 << g;
    const bf16_t* base = Z + (size_t)sb * NZ + 1536 + lane * 8;
    float sum[8], tmp[8];
#pragma unroll
    for (int j = 0; j < 8; ++j) sum[j] = 0.f;
    for (int j = 0; j < 16; ++j) { const int r = t0 - hw + j;
        if (j < 2 * hw && r >= 0 && r < S) { unpack8(*(const u32x4*)(base + (size_t)r * NZ), tmp);
#pragma unroll
            for (int e = 0; e < 8; ++e) sum[e] += tmp[e]; } }
    for (int i = 0; i < 16; ++i) { const int t = t0 + i;
        int lo = t - hw; if (lo < 0) lo = 0; int hi2 = t + hw - 1; if (hi2 > S - 1) hi2 = S - 1;
        const float inv = 1.0f / (float)(hi2 - lo + 1);
        float self[8]; unpack8(*(const u32x4*)(base + (size_t)t * NZ), self);
        u32x4 o; o.x = pk2(sum[0] * inv - self[0], sum[1] * inv - self[1]); o.y = pk2(sum[2] * inv - self[2], sum[3] * inv - self[3]);
        o.z = pk2(sum[4] * inv - self[4], sum[5] * inv - self[5]); o.w = pk2(sum[6] * inv - self[6], sum[7] * inv - self[7]);
        *(u32x4*)(A2 + (size_t)(sb + t) * DM + 512 + lane * 8) = o;
        const int radd = t + hw, rsub = t - hw;
        if (radd < S) { unpack8(*(const u32x4*)(base + (size_t)radd * NZ), tmp);
#pragma unroll
            for (int e = 0; e < 8; ++e) sum[e] += tmp[e]; }
        if (rsub >= 0) { unpack8(*(const u32x4*)(base + (size_t)rsub * NZ), tmp);
#pragma unroll
            for (int e = 0; e < 8; ++e) sum[e] -= tmp[e]; }
    }
}
}

#define XB_TMO      128
#define XB_XCNT(j)  (256  + 64 * (j))
#define XB_XSUB(j)  (1280 + 64 * (j))
#define XB_XGEN(j)  (2304 + 64 * (j))
#define XB_TOP      3328
#define XB_TOPGEN   3392
#define XCD_BAR_WORDS 3456
#define XB_SPIN_CAP (1u << 22)
__device__ __forceinline__ unsigned xb_ld(unsigned* p)              { return __hip_atomic_load(p, __ATOMIC_RELAXED, __HIP_MEMORY_SCOPE_AGENT); }
__device__ __forceinline__ unsigned xb_add(unsigned* p, unsigned v) { return __hip_atomic_fetch_add(p, v, __ATOMIC_RELAXED, __HIP_MEMORY_SCOPE_AGENT); }
__device__ __forceinline__ unsigned xb_xcc_id() { return (unsigned)__builtin_amdgcn_s_getreg((3 << 11) | 20) & 0xFu; }
#define XB_SPIN(cond, bar) do { unsigned _sp = 0; while (cond) { __builtin_amdgcn_s_sleep(1); \
    if ((++_sp & 255u) == 0u) { if (xb_ld(&(bar)[XB_TMO])) break; if (_sp > XB_SPIN_CAP) { atomicAdd(&(bar)[XB_TMO], 1u); break; } } } } while (0)
struct XcdBarrier { unsigned* bar; unsigned x; volatile LAS unsigned* st; };
__device__ __forceinline__ XcdBarrier xcd_barrier_post(unsigned* bar, volatile LAS unsigned* st) {
    XcdBarrier b; b.bar = bar; b.x = xb_xcc_id(); b.st = st;
    if (threadIdx.x == 0) (void)xb_add(&bar[XB_XCNT(b.x)], 1u);
    return b;
}
__device__ __forceinline__ void xcd_barrier_complete(unsigned* bar, unsigned x, unsigned& nloc, unsigned& nx) {
    const unsigned G = gridDim.x * gridDim.y * gridDim.z;
    unsigned sum, cnt, mine, sp = 0u;
    for (;;) {
        sum = 0u; cnt = 0u; mine = 0u;
#pragma unroll
        for (unsigned j = 0; j < 16; ++j) { const unsigned c = xb_ld(&bar[XB_XCNT(j)]); sum += c; cnt += (c > 0u) ? 1u : 0u; mine = (j == x) ? c : mine; }
        if (sum == G) break;
        __builtin_amdgcn_s_sleep(1);
        if ((++sp & 255u) == 0u) { if (xb_ld(&bar[XB_TMO])) break; if (sp > XB_SPIN_CAP) { atomicAdd(&bar[XB_TMO], 1u); break; } }
    }
    nloc = mine > 0u ? mine : 1u; nx = cnt > 0u ? cnt : 1u;
}
__device__ __forceinline__ void xcd_barrier(const XcdBarrier& b) {
    asm volatile("s_waitcnt vmcnt(0)" ::: "memory");
    __syncthreads();
    if (threadIdx.x == 0) {
        unsigned* bar = b.bar;
        __builtin_amdgcn_s_waitcnt(0);
        unsigned nloc = b.st[0], nx = b.st[1];
        if (nloc == 0u) { xcd_barrier_complete(bar, b.x, nloc, nx); b.st[0] = nloc; b.st[1] = nx; }
        const unsigned old = xb_add(&bar[XB_XSUB(b.x)], 1u);
        const unsigned gen = old / nloc;
        if (old + 1u == (gen + 1u) * nloc) {
            __builtin_amdgcn_fence(__ATOMIC_RELEASE, "agent");
            asm volatile("s_waitcnt vmcnt(0)" ::: "memory");
            const unsigned og = xb_add(&bar[XB_TOP], 1u);
            const unsigned tg = og / nx;
            if (og + 1u == (tg + 1u) * nx) xb_add(&bar[XB_TOPGEN], 1u);
            else XB_SPIN(xb_ld(&bar[XB_TOPGEN]) == tg, bar);
            __builtin_amdgcn_fence(__ATOMIC_ACQUIRE, "agent");
            xb_add(&bar[XB_XGEN(b.x)], 1u);
            asm volatile("s_waitcnt vmcnt(0)" ::: "memory");
        } else {
            XB_SPIN(xb_ld(&bar[XB_XGEN(b.x)]) == gen, bar);
            __builtin_amdgcn_fence(__ATOMIC_ACQUIRE, "agent");
            asm volatile("s_waitcnt vmcnt(0)" ::: "memory");
        }
    }
    __syncthreads();
}

typedef const char __attribute__((address_space(4)))* karg_t;
__device__ __forceinline__ const float* karg_ptr(int byte_off) { karg_t ka = (karg_t)__builtin_amdgcn_kernarg_segment_ptr(); asm volatile("" : "+s"(ka)); return *(const float* const __attribute__((address_space(4)))*)(ka + byte_off); }
#define PIN(i) karg_ptr(8 * (i))
struct Params { const float* in[18]; float* out; unsigned char* ws; int ph_lo, ph_hi; };
enum { I_XP = 0, I_XS, I_RELB, I_LNMPRE, I_LNMPOST, I_WIN, I_LAMQ, I_LAMK, I_HNORM, I_WPOOL, I_PSCALE, I_WOUT, I_LNFPRE, I_LNFPOST, I_WUP, I_CONVW, I_CONVB, I_WDOWN };
constexpr int NPHASE = 1 + 9 * NLAYER;

template <class Src, class RowMap>
__device__ __forceinline__ void tconv_item(LAS float* scr, bf16_t* WT, int K, int k0, int n0, int lane, const Src& src, const RowMap& rm) {
#pragma unroll 8
    for (int i = 0; i < 32; ++i) { const int kk = 2 * i + (lane >> 5); scr[kk * 33 + (lane & 31)] = src(k0 + kk, n0 + (lane & 31)); }
    asm volatile("s_waitcnt lgkmcnt(0)" ::: "memory");
    const int c = lane & 7;
#pragma unroll
    for (int j = 0; j < 4; ++j) { const int n = (lane >> 3) + 8 * j; const LAS float* s = scr + (8 * c) * 33 + n;
        u32x4 o; o.x = pk2(s[0], s[33]); o.y = pk2(s[2 * 33], s[3 * 33]); o.z = pk2(s[4 * 33], s[5 * 33]); o.w = pk2(s[6 * 33], s[7 * 33]);
        *(u32x4*)(WT + (size_t)rm(n0 + n) * K + k0 + 8 * c) = o; }
    asm volatile("s_waitcnt lgkmcnt(0)" ::: "memory");
}

__device__ __forceinline__ int t5_bucket(int rel) {
    const int ret = rel > 0 ? 16 : 0; const int n = rel < 0 ? -rel : rel;
    if (n < 8) return ret + n;
    int lg = 31 - __clz(n * n);
    int large = 8 + (lg - 6); if (large > 15) large = 15;
    return ret + large;
}

__device__ __forceinline__ void resid_rows(bf16_t* R, const bf16_t* Y, const float* ssqY, const float* g, float* rstd_out, float* outf, bool wf32, int row_lo, int row_hi, int yoff, int gw, int NGW, int lane) {
    constexpr int RP = 4;
    f32x4 gv[2][2];
#pragma unroll
    for (int j = 0; j < 2; ++j) { gv[j][0] = *(const f32x4*)(g + 8 * lane + 512 * j); gv[j][1] = *(const f32x4*)(g + 8 * lane + 512 * j + 4); }
    for (int row0 = row_lo + gw; row0 < row_hi; row0 += RP * NGW) {
        u32x4 rr[RP][2], oo[RP][2]; float ssv[RP];
#pragma unroll
        for (int k = 0; k < RP; ++k) { const int row = row0 + k * NGW; const bool ok = row < row_hi; const int rw = ok ? row : row0;
            ssv[k] = ssqY[rw];
#pragma unroll
            for (int j = 0; j < 2; ++j) { const int c = 8 * lane + 512 * j; rr[k][j] = *(const u32x4*)(R + (size_t)rw * DM + c); oo[k][j] = *(const u32x4*)(Y + (size_t)(rw - yoff) * DM + c); } }
#pragma unroll
        for (int k = 0; k < RP; ++k) { const int row = row0 + k * NGW; if (row < row_hi) {
            const float rs = __builtin_amdgcn_rsqf(ssv[k] * (1.0f / DM) + RMS_EPS); float s = 0.f;
#pragma unroll
            for (int j = 0; j < 2; ++j) { const int c = 8 * lane + 512 * j; const u32x4 r = rr[k][j], o = oo[k][j]; const f32x4 ga = gv[j][0], gb = gv[j][1];
                f32x4 ya, yb; ya[0] = bflo(r.x) + bflo(o.x) * rs * ga[0]; ya[1] = bfhi(r.x) + bfhi(o.x) * rs * ga[1]; ya[2] = bflo(r.y) + bflo(o.y) * rs * ga[2]; ya[3] = bfhi(r.y) + bfhi(o.y) * rs * ga[3];
                yb[0] = bflo(r.z) + bflo(o.z) * rs * gb[0]; yb[1] = bfhi(r.z) + bfhi(o.z) * rs * gb[1]; yb[2] = bflo(r.w) + bflo(o.w) * rs * gb[2]; yb[3] = bfhi(r.w) + bfhi(o.w) * rs * gb[3];
                if (wf32) { *(f32x4*)(outf + (size_t)row * DM + c) = ya; *(f32x4*)(outf + (size_t)row * DM + c + 4) = yb; }
                s += (ya[0] * ya[0] + ya[1] * ya[1]) + (ya[2] * ya[2] + ya[3] * ya[3]) + (yb[0] * yb[0] + yb[1] * yb[1]) + (yb[2] * yb[2] + yb[3] * yb[3]);
                u32x4 w; w.x = pk2(ya[0], ya[1]); w.y = pk2(ya[2], ya[3]); w.z = pk2(yb[0], yb[1]); w.w = pk2(yb[2], yb[3]); *(u32x4*)(R + (size_t)row * DM + c) = w; }
            s = wave_sum(s); if (lane == 0) rstd_out[row] = __builtin_amdgcn_rsqf(s * (1.0f / DM) + RMS_EPS); } }
    }
}

__global__ void __launch_bounds__(512, 2) fwd_megakernel(Params P) {
    extern __shared__ __attribute__((aligned(16))) unsigned char lds_raw[];
    LAS unsigned char* lds = (LAS unsigned char*)lds_raw;
    const int tid = threadIdx.x, lane = tid & 63, wave = tid >> 6, G = gridDim.x, bx = blockIdx.x;
    const int gw = bx * 8 + wave, NGW = G * 8;
#define ws ((unsigned char*)karg_ptr(152))
#define XB ((bf16_t*)(ws + OFF_XB))
#define A2 ((bf16_t*)out)
#define FH0 ((bf16_t*)(ws + OFF_Z + OFF_FH0))
#define FH1 ((bf16_t*)out)
#define Zb ((bf16_t*)(ws + OFF_Z))
#define OB Zb
#define GB Zb
#define rstdA ((float*)(ws + OFF_RSTD_A))
#define rstdB ((float*)(ws + OFF_RSTD_B))
#define ssq ((float*)(ws + OFF_SSQ))
#define tabg ((float*)(ws + OFF_TAB))
#define out ((float*)karg_ptr(144))
    volatile LAS unsigned* xst = (volatile LAS unsigned*)(lds + LDS_BYTES - 16);
    if (tid == 0) { xst[0] = 0u; xst[1] = 0u; }
    __syncthreads();
    if (P.ph_hi - P.ph_lo > 1) (void)xcd_barrier_post((unsigned*)(ws + OFF_BAR), xst);
#ifndef PHMASK
#define PHMASK 0xff
#endif
#define EN(t) (((PHMASK) >> (t)) & 1)
#define IN(k) (P.ph_lo <= (k) && (k) < P.ph_hi)
#define SEAM(k) do { if (IN(k) && IN((k) + 1)) { if (P.ph_lo == 0x7fffffff) cg::this_grid().sync();   { XcdBarrier xb_; xb_.bar = (unsigned*)(ws + OFF_BAR); xb_.x = xb_xcc_id(); xb_.st = (volatile LAS unsigned*)(lds + LDS_BYTES - 16); xcd_barrier(xb_); } } } while (0)

    if (EN(0) && IN(0)) {
        { const int lane_ = otid() & 63, wv_ = otid() >> 6, gwv = bx * 8 + wv_, ngw = G * 8;
          LAS float* scr = (LAS float*)lds + wv_ * (64 * 33);
          auto rid = [](int n) { return n; };
          for (int l = 0; l < NLAYER; ++l) {
            const float lam_init = 0.8f - 0.6f * expf(-0.3f * (float)l);
            {
                const float* W = PIN(I_WIN) + (size_t)l * DM * NZ; const float* gpre = PIN(I_LNMPRE) + l * DM; bf16_t* WT = (bf16_t*)(ws + OFF_WIN + l * SZ_WIN);
                auto src = [=](int k, int n) { return W[(size_t)k * NZ + n] * gpre[k] * (n < 512 ? QSCALE : 1.0f); };
                for (int it = gwv; it < 16 * 64; it += ngw) tconv_item(scr, WT, DM, (it >> 6) * 64, (it & 63) * 32, lane_, src, rid);
            }
            {
                const float* W = PIN(I_WOUT) + (size_t)l * DM * DM; const float* hn = PIN(I_HNORM) + l * 128; bf16_t* WT = (bf16_t*)(ws + OFF_WOUT + l * SZ_WOUT); const float hs = 1.0f - lam_init;
                auto src = [=](int k, int n) { return W[(size_t)k * DM + n] * hn[k & 127] * hs; };
                for (int it = gwv; it < 8 * 32; it += ngw) tconv_item(scr, WT, DM, (it >> 5) * 64, (it & 31) * 32, lane_, src, rid);
            }
            {
                const float* W = PIN(I_WOUT) + (size_t)l * DM * DM; const float* wp = PIN(I_WPOOL) + (size_t)l * 4 * 128 * 128; const float* ps = PIN(I_PSCALE) + l * 512;
                bf16_t* WT = (bf16_t*)(ws + OFF_WOUT + l * SZ_WOUT);
                for (int it = gwv; it < 4 * 4 * 32; it += ngw) {
                    const int g = it >> 7, ci = (it >> 5) & 3, nj = it & 31, kh = lane_ >> 5, l31 = lane_ & 31;
                    const float* wrow = wp + ((size_t)g * 128 + ci * 32 + l31) * 128; const float* psg = ps + g * 128; const float* wo = W + (size_t)(512 + g * 128) * DM + nj * 32 + l31;
                    f32x16 acc;
#pragma unroll
                    for (int r = 0; r < 16; ++r) acc[r] = 0.f;
#pragma unroll 8
                    for (int kk = 0; kk < 64; ++kk) { const int d = 2 * kk + kh; acc = __builtin_amdgcn_mfma_f32_32x32x2f32(wrow[d] * psg[d], wo[(size_t)d * DM], acc, 0, 0, 0); }
                    bf16_t* orow = WT + (size_t)(nj * 32 + l31) * DM + 512 + g * 128 + ci * 32 + 4 * kh;
#pragma unroll
                    for (int q = 0; q < 4; ++q) { u32x2 o; o.x = pk2(acc[4 * q], acc[4 * q + 1]); o.y = pk2(acc[4 * q + 2], acc[4 * q + 3]); *(u32x2*)(orow + 8 * q) = o; }
                }
            }
            {
                const float* W = PIN(I_WUP) + (size_t)l * DM * NUP; const float* gpre = PIN(I_LNFPRE) + l * DM; bf16_t* WT = (bf16_t*)(ws + OFF_WUP + l * SZ_WUP);
                auto src = [=](int k, int n) { return W[(size_t)k * NUP + n] * gpre[k]; };
                auto rm = [](int n) { return n < DFF ? ((n >> 7) * 256 + (n & 127)) : (((n - DFF) >> 7) * 256 + 128 + ((n - DFF) & 127)); };
                for (int it = gwv; it < 16 * 176; it += ngw) tconv_item(scr, WT, DM, (it / 176) * 64, (it % 176) * 32, lane_, src, rm);
            }
            {
                const float* W = PIN(I_WDOWN) + (size_t)l * DFF * DM; bf16_t* WT = (bf16_t*)(ws + OFF_WDN + l * SZ_WDN);
                auto src = [=](int k, int n) { return W[(size_t)k * DM + n]; };
                for (int it = gwv; it < 44 * 32; it += ngw) tconv_item(scr, WT, DFF, (it >> 5) * 64, (it & 31) * 32, lane_, src, rid);
            }
          }
        }
        for (int row0 = gw; row0 < MTOK; row0 += 4 * NGW) {
            f32x4 xa[4][2][2];
#pragma unroll
            for (int k = 0; k < 4; ++k) { const int row = row0 + k * NGW; const float* xr = row < 16384 ? PIN(I_XP) + (size_t)row * DM : PIN(I_XS) + (size_t)(row - 16384) * DM;
#pragma unroll
                for (int j = 0; j < 2; ++j) { xa[k][j][0] = *(const f32x4*)(xr + 8 * lane + 512 * j); xa[k][j][1] = *(const f32x4*)(xr + 8 * lane + 512 * j + 4); } }
#pragma unroll
            for (int k = 0; k < 4; ++k) { const int row = row0 + k * NGW; float s = 0.f;
#pragma unroll
                for (int j = 0; j < 2; ++j) { const f32x4 a = xa[k][j][0], b = xa[k][j][1];
                    s += (a[0] * a[0] + a[1] * a[1]) + (a[2] * a[2] + a[3] * a[3]) + (b[0] * b[0] + b[1] * b[1]) + (b[2] * b[2] + b[3] * b[3]);
                    u32x4 o; o.x = pk2(a[0], a[1]); o.y = pk2(a[2], a[3]); o.z = pk2(b[0], b[1]); o.w = pk2(b[2], b[3]); *(u32x4*)(XB + (size_t)row * DM + 8 * lane + 512 * j) = o; }
                s = wave_sum(s); if (lane == 0) rstdA[row] = __builtin_amdgcn_rsqf(s * (1.0f / DM) + RMS_EPS); }
        }
        for (int i = bx * 512 + tid; i < NLAYER * 2 * MTOK; i += G * 512) ssq[i] = 0.f;
        if (bx == 0) for (int i = tid; i < 4 * 257; i += 512) { const int h = i / 257, d = i % 257 - 128; tabg[i] = PIN(I_RELB)[t5_bucket(d) * 4 + h] * LOG2E; }
    }
    SEAM(0);

#pragma unroll 1
    for (int l = 0; l < NLAYER; ++l) {
        const int pb = 1 + 9 * l;
        float* ssqO = ssq + (size_t)(l * 2 + 0) * MTOK; float* ssqF = ssq + (size_t)(l * 2 + 1) * MTOK;
        if (EN(1) && IN(pb + 0)) {
            pg8::Gemm g{XB, (const bf16_t*)(ws + OFF_WIN + l * SZ_WIN), MTOK, NZ, DM}; pg8::StaticOrder S; S.init(MTOK, NZ, G, bx);
            pg8::EpiScale E{Zb, NZ, rstdA};
            pg8::gemm_phase<pg8::EpiScale, false>(lds, g, S, E);
        }
        SEAM(pb + 0);
        if (EN(2) && IN(pb + 1)) {
            float lam;
            { const int lane = otid() & 63; const float* lq = PIN(I_LAMQ) + l * 128; const float* lk = PIN(I_LAMK) + l * 128;
              const float a = wave_sum(lq[lane] * lk[lane]), b = wave_sum(lq[64 + lane] * lk[64 + lane]);
              lam = expf(a) - expf(b) + (0.8f - 0.6f * expf(-0.3f * (float)l)); }
            { const int lane_ = otid() & 63, gwv = bx * 8 + (otid() >> 6);
              for (int tb = gwv; tb < MTOK / 16; tb += G * 8) att::pool_block(Zb, A2, tb * 16, lane_); }
            __syncthreads();
            for (int u = bx; u < 1024; u += G) {
                const int kind = u >> 9, v = u & 511, i = v >> 8, b = v & 255, xc = b & 7, j = b >> 3;
                if (kind == 0) att::attn_unit(lds, Zb, A2, tabg, 16384, 16384, xc >> 1, (xc & 1) * 64 + i * 32 + j, lam);
                else att::attn_unit(lds, Zb, A2, tabg, (xc >> 2) * 8192, 8192, xc & 3, i * 32 + j, lam);
            }
        }
        SEAM(pb + 1);
        if (EN(3) && IN(pb + 2)) {
            pg8::Gemm g{A2, (const bf16_t*)(ws + OFF_WOUT + l * SZ_WOUT), MTOK, DM, DM}; pg8::StaticOrder S; S.init(MTOK, DM, G, bx);
            pg8::EpiSsq E{OB, DM, ssqO};
            pg8::gemm_phase<pg8::EpiSsq, false>(lds, g, S, E);
        }
        SEAM(pb + 2);
        if (EN(4) && IN(pb + 3)) {
            const int lane = otid() & 63, gw = bx * 8 + (otid() >> 6);
            resid_rows(XB, OB, ssqO, PIN(I_LNMPOST) + l * DM, rstdB, nullptr, false, 0, MTOK, 0, gw, NGW, lane);
        }
        SEAM(pb + 3);
#pragma unroll 1
        for (int hh = 0; hh < 2; ++hh) {
            const int T0 = hh * HALF_TOK;
            if (EN(5) && IN(pb + 4 + 2 * hh)) {
                pg8::Gemm g{XB + (size_t)(T0 - 1) * DM, (const bf16_t*)(ws + OFF_WUP + l * SZ_WUP), UP_TILES * 256, NUP, DM}; pg8::StaticOrder S; S.init(UP_TILES * 256, NUP, G, bx);
                pg8::EpiUp E{GB, rstdB, PIN(I_CONVW) + (size_t)l * 3 * NUP, PIN(I_CONVB) + (size_t)l * NUP, T0};
                pg8::gemm_phase<pg8::EpiUp, true>(lds, g, S, E);
            }
            SEAM(pb + 4 + 2 * hh);
            if (EN(6) && IN(pb + 5 + 2 * hh)) {
                pg8::Gemm g{GB, (const bf16_t*)(ws + OFF_WDN + l * SZ_WDN), HALF_TOK, DM, DFF}; pg8::StaticOrder S; S.init(HALF_TOK, DM, G, bx);
                pg8::EpiSsq E{hh == 0 ? FH0 : FH1, DM, ssqF + T0};
                pg8::gemm_phase<pg8::EpiSsq, false>(lds, g, S, E);
            }
            SEAM(pb + 5 + 2 * hh);
        }
        if (EN(7) && IN(pb + 8)) {
            const bool lastl = (l == NLAYER - 1);
            { const int lane = otid() & 63, gw = bx * 8 + (otid() >> 6);
              resid_rows(XB, FH1, ssqF, PIN(I_LNFPOST) + l * DM, rstdA, out, lastl, HALF_TOK, MTOK, HALF_TOK, gw, NGW, lane); }
            if (lastl && (P.ph_hi - P.ph_lo > 1)) { XcdBarrier xb_; xb_.bar = (unsigned*)(ws + OFF_BAR); xb_.x = xb_xcc_id(); xb_.st = (volatile LAS unsigned*)(lds + LDS_BYTES - 16); xcd_barrier(xb_); }
            { const int lane = otid() & 63, gw = bx * 8 + (otid() >> 6);
              resid_rows(XB, FH0, ssqF, PIN(I_LNFPOST) + l * DM, rstdA, out, lastl, 0, HALF_TOK, 0, gw, NGW, lane); }
        }
        SEAM(pb + 8);
    }
#undef IN
#undef SEAM
#undef ws
#undef out
#undef XB
#undef A2
#undef FH0
#undef FH1
#undef Zb
#undef OB
#undef GB
#undef rstdA
#undef rstdB
#undef ssq
#undef tabg
}

extern "C" void kernel_launch(void* const* d_in, const int* in_sizes, int n_in, void* d_out, int out_size, void* d_ws, size_t ws_size, hipStream_t stream) {
    static int grid = 0;
    if (grid == 0) {
        if (n_in != 18 || out_size != MTOK * DM || ws_size < WS_NEED) { fprintf(stderr, "kernel_launch: unexpected shapes: n_in %d out %d ws %zu (need %zu)\n", n_in, out_size, ws_size, (size_t)WS_NEED); grid = -1; return; }
        int dev = 0, cus = 0, per_cu = 0;
        (void)hipGetDevice(&dev); (void)hipDeviceGetAttribute(&cus, hipDeviceAttributeMultiprocessorCount, dev);
        if (hipFuncSetAttribute((const void*)fwd_megakernel, hipFuncAttributeMaxDynamicSharedMemorySize, LDS_BYTES) != hipSuccess) { fprintf(stderr, "kernel_launch: hipFuncSetAttribute failed\n"); grid = -1; return; }
        (void)hipOccupancyMaxActiveBlocksPerMultiprocessor(&per_cu, (const void*)fwd_megakernel, 512, LDS_BYTES);
        (void)hipGetLastError();
        if (per_cu < 1) per_cu = 1;
        grid = cus * 1;
        if (grid <= 0) grid = 256;
    }
    if (grid < 0) return;
    (void)hipMemsetAsync((char*)d_ws + OFF_BAR, 0, 3456 * 4, stream);
    Params p{};
    for (int i = 0; i < 18; ++i) p.in[i] = (const float*)d_in[i];
    p.out = (float*)d_out; p.ws = (unsigned char*)d_ws;
#if MK_MULTI
    for (int ph = 0; ph < NPHASE; ++ph) { p.ph_lo = ph; p.ph_hi = ph + 1; hipLaunchKernelGGL(fwd_megakernel, dim3(grid), dim3(512), LDS_BYTES, stream, p); }
#else
    p.ph_lo = 0; p.ph_hi = NPHASE;
    void* args[] = {&p};
    hipError_t e = hipLaunchCooperativeKernel((const void*)fwd_megakernel, dim3(grid), dim3(512), args, LDS_BYTES, stream);
    if (e != hipSuccess) fprintf(stderr, "cooperative launch failed: %s (grid %d)\n", hipGetErrorString(e), grid);
#endif
}
```
